# Optimizing an MI355X kernel written in HIP

```python
import math
import jax, jax.numpy as jnp
from jax import lax
import numpy as np

D_MODEL = 1024
BATCH = 2
SEQ = 8192
DEPTH = 1

D_MIX = D_MODEL
D_MLSTM = D_MIX // 2
D_S5 = D_MIX - D_MLSTM
MLSTM_HEADS = 4
MLSTM_HEAD_DIM = D_MLSTM // MLSTM_HEADS
MLSTM_CHUNK = 64
CONV_WIDTH = 4
S5_GROUP_CH = 16
S5_GROUPS = D_S5 // S5_GROUP_CH
S5_STATE = 64
D_IN_PROJ = 4 * D_MLSTM + 2 * MLSTM_HEADS + D_S5
N_EXPERT_GROUPS = 4
EXPERTS_PER_GROUP = 8
N_EXPERTS = N_EXPERT_GROUPS * EXPERTS_PER_GROUP
TOP_K_IN_GROUP = 2
D_EXPERT = 512
EPS = 1e-6
LAMBDA_RE_MAX = -1e-4

kernel_name = "hymba_mlstm_s5_hiermoe_block"


def rmsnorm(x, g):
    xf = x.astype(jnp.float32)
    y = xf * lax.rsqrt(jnp.mean(xf * xf, axis=-1, keepdims=True) + EPS) * g.astype(jnp.float32)
    return y.astype(x.dtype)


def causal_depthwise_conv(x, w, b):
    L = x.shape[1]
    W = w.shape[0]
    xp = jnp.pad(x, ((0, 0), (W - 1, 0), (0, 0)))
    out = b
    for j in range(W):
        out = out + xp[:, j:j + L, :] * w[j]
    return out


def mlstm_chunkwise(q, k, v, log_i, log_f):
    Bsz, H, L, d = q.shape
    nc = L // MLSTM_CHUNK

    def chunks(a):
        a = a.reshape(a.shape[:2] + (nc, MLSTM_CHUNK) + a.shape[3:])
        return jnp.moveaxis(a, 2, 0)

    mask = jnp.tril(jnp.ones((MLSTM_CHUNK, MLSTM_CHUNK), dtype=bool))

    def step(carry, inp):
        C, n, m = carry
        qc, kc, vc, li, lf = inp
        b = jnp.cumsum(lf, axis=-1)
        dmat = b[..., :, None] - b[..., None, :] + li[..., None, :]
        dmat = jnp.where(mask, dmat, -jnp.inf)
        inter = b + m[..., None]
        m_row = jnp.maximum(inter, jnp.max(dmat, axis=-1))
        w_intra = jnp.exp(dmat - m_row[..., None])
        w_inter = jnp.exp(inter - m_row)
        s = jnp.einsum('bhjd,bhsd->bhjs', qc, kc) * w_intra
        num = jnp.einsum('bhjs,bhsd->bhjd', s, vc) + w_inter[..., None] * jnp.einsum('bhvk,bhjk->bhjv', C, qc)
        den = jnp.sum(s, axis=-1) + w_inter * jnp.einsum('bhk,bhjk->bhj', n, qc)
        h = num / jnp.maximum(jnp.abs(den), jnp.exp(-m_row))[..., None]
        b_last = b[..., -1]
        d_state = b_last[..., None] - b + li
        m_new = jnp.maximum(b_last + m, jnp.max(d_state, axis=-1))
        w_s = jnp.exp(d_state - m_new[..., None])
        w_c = jnp.exp(b_last + m - m_new)
        C_new = w_c[..., None, None] * C + jnp.einsum('bhs,bhsv,bhsk->bhvk', w_s, vc, kc)
        n_new = w_c[..., None] * n + jnp.einsum('bhs,bhsk->bhk', w_s, kc)
        return (C_new, n_new, m_new), h

    init = (jnp.zeros((Bsz, H, d, d), jnp.float32),
            jnp.zeros((Bsz, H, d), jnp.float32),
            jnp.zeros((Bsz, H), jnp.float32))
    _, h = lax.scan(step, init, (chunks(q), chunks(k), chunks(v), chunks(log_i), chunks(log_f)))
    h = jnp.moveaxis(h, 0, 2)
    return h.reshape(Bsz, H, L, d)


def s5_combine(e1, e2):
    a1r, a1i, b1r, b1i = e1
    a2r, a2i, b2r, b2i = e2
    return (a2r * a1r - a2i * a1i,
            a2r * a1i + a2i * a1r,
            a2r * b1r - a2i * b1i + b2r,
            a2r * b1i + a2i * b1r + b2i)


def s5_group_mixer(u, lam_re, lam_im, log_dt, b_re, b_im, c_re, c_im, d_skip, glu_w, glu_b):
    f32 = jnp.float32
    lr = jnp.minimum(lam_re.astype(f32), LAMBDA_RE_MAX)
    li = lam_im.astype(f32)
    dt = jnp.exp(log_dt.astype(f32))[:, None]
    mag = jnp.exp(lr * dt)
    ar = mag * jnp.cos(li * dt)
    ai = mag * jnp.sin(li * dt)
    den = lr * lr + li * li
    cr = ((ar - 1.0) * lr + ai * li) / den
    ci = (ai * lr - (ar - 1.0) * li) / den
    br, bi = b_re.astype(f32), b_im.astype(f32)
    bbar_r = cr[..., None] * br - ci[..., None] * bi
    bbar_i = cr[..., None] * bi + ci[..., None] * br
    bu_r = jnp.einsum('blgh,gnh->blgn', u, bbar_r)
    bu_i = jnp.einsum('blgh,gnh->blgn', u, bbar_i)
    a_r = jnp.broadcast_to(ar, bu_r.shape)
    a_i = jnp.broadcast_to(ai, bu_i.shape)
    _, _, s_r, s_i = lax.associative_scan(s5_combine, (a_r, a_i, bu_r, bu_i), axis=1)
    y = (jnp.einsum('blgn,ghn->blgh', s_r, c_re.astype(f32))
         - jnp.einsum('blgn,ghn->blgh', s_i, c_im.astype(f32))
         + d_skip.astype(f32) * u)
    y = jax.nn.gelu(y)
    z = jnp.einsum('blgh,ghc->blgc', y, glu_w.astype(f32)) + glu_b.astype(f32)
    return z[..., :S5_GROUP_CH] * jax.nn.sigmoid(z[..., S5_GROUP_CH:])


def hybrid_mixer(h, w_in, conv_w, conv_b, i_bias, f_bias, mlstm_norm_g,
                 lam_re, lam_im, log_dt, b_re, b_im, c_re, c_im, d_skip, glu_w, glu_b, w_out):
    f32 = jnp.float32
    Bsz, L, _ = h.shape
    H, d = MLSTM_HEADS, MLSTM_HEAD_DIM
    proj = (h @ w_in).astype(f32)
    qk_raw = proj[..., :2 * D_MLSTM]
    v = proj[..., 2 * D_MLSTM:3 * D_MLSTM]
    o_pre = proj[..., 3 * D_MLSTM:4 * D_MLSTM]
    i_pre = proj[..., 4 * D_MLSTM:4 * D_MLSTM + H] + i_bias.astype(f32)
    f_pre = proj[..., 4 * D_MLSTM + H:4 * D_MLSTM + 2 * H] + f_bias.astype(f32)
    u = proj[..., 4 * D_MLSTM + 2 * H:]

    qk = jax.nn.silu(causal_depthwise_conv(qk_raw, conv_w.astype(f32), conv_b.astype(f32)))
    q, k = qk[..., :D_MLSTM], qk[..., D_MLSTM:]

    def heads(a):
        return a.reshape(Bsz, L, H, d).transpose(0, 2, 1, 3)

    log_i = i_pre.transpose(0, 2, 1)
    log_f = jax.nn.log_sigmoid(f_pre).transpose(0, 2, 1)
    h_m = mlstm_chunkwise(heads(q), heads(k) * (d ** -0.5), heads(v), log_i, log_f)
    h_m = h_m * lax.rsqrt(jnp.mean(h_m * h_m, axis=-1, keepdims=True) + EPS)
    h_m = h_m.transpose(0, 2, 1, 3).reshape(Bsz, L, D_MLSTM) * mlstm_norm_g.astype(f32)
    out_a = jax.nn.sigmoid(o_pre) * h_m

    out_b = s5_group_mixer(u.reshape(Bsz, L, S5_GROUPS, S5_GROUP_CH), lam_re, lam_im, log_dt,
                           b_re, b_im, c_re, c_im, d_skip, glu_w, glu_b).reshape(Bsz, L, D_S5)

    merged = jnp.concatenate([out_a, out_b], axis=-1).astype(h.dtype)
    return merged @ w_out


def hierarchical_moe(h, rg_w, rg_b, re_w, re_b, w_gate, w_up, w_down):
    f32 = jnp.float32
    Bsz, L, D = h.shape
    t = h.reshape(Bsz * L, D)
    T = t.shape[0]
    g_logits = (t @ rg_w).astype(f32) + rg_b.astype(f32)
    p_g = jax.nn.softmax(g_logits, axis=-1)
    g_w, g_idx = lax.top_k(p_g, 1)
    e_logits = ((t @ re_w).astype(f32) + re_b.astype(f32)).reshape(T, N_EXPERT_GROUPS, EXPERTS_PER_GROUP)
    e_logits = jnp.take_along_axis(e_logits, g_idx[:, :, None], axis=1)[:, 0]
    p_e = jax.nn.softmax(e_logits, axis=-1)
    e_w, e_idx = lax.top_k(p_e, TOP_K_IN_GROUP)
    e_w = e_w / jnp.sum(e_w, axis=-1, keepdims=True)
    weights = g_w * e_w
    expert_id = g_idx * EXPERTS_PER_GROUP + e_idx
    combine = jnp.einsum('tk,tke->te', weights, jax.nn.one_hot(expert_id, N_EXPERTS, dtype=f32))
    combine = combine.astype(h.dtype)
    y = jnp.zeros_like(t)
    for e in range(N_EXPERTS):
        ye = (jax.nn.silu(t @ w_gate[e]) * (t @ w_up[e])) @ w_down[e]
        y = y + combine[:, e:e + 1] * ye
    return y.reshape(Bsz, L, D)


def setup_inputs(seed: int = 0) -> dict:
    key = jax.random.key(seed)
    ks = jax.random.split(key, 32)
    f32 = jnp.float32
    nrm = lambda k, shape, s: jax.random.normal(k, shape, f32) * s
    H = MLSTM_HEADS
    G, N, C = S5_GROUPS, S5_STATE, S5_GROUP_CH
    x = jax.random.normal(ks[0], (BATCH, SEQ, D_MODEL), f32)
    norm_mix_g = 1.0 + nrm(ks[1], (DEPTH, D_MODEL), 0.02)
    w_in = nrm(ks[2], (DEPTH, D_MODEL, D_IN_PROJ), D_MODEL ** -0.5)
    conv_w = nrm(ks[3], (DEPTH, CONV_WIDTH, 2 * D_MLSTM), CONV_WIDTH ** -0.5)
    conv_b = nrm(ks[4], (DEPTH, 2 * D_MLSTM), 0.01)
    i_bias = nrm(ks[5], (DEPTH, H), 0.1)
    f_bias = jnp.linspace(3.0, 6.0, H, dtype=f32)[None, :] + nrm(ks[6], (DEPTH, H), 0.1)
    mlstm_norm_g = 1.0 + nrm(ks[7], (DEPTH, D_MLSTM), 0.02)
    s5_lambda_re = -0.5 + nrm(ks[8], (DEPTH, G, N), 0.01)
    s5_lambda_im = math.pi * jnp.arange(N, dtype=f32)[None, None, :] + nrm(ks[9], (DEPTH, G, N), 0.01)
    s5_log_dt = jax.random.uniform(ks[10], (DEPTH, G), f32, math.log(0.001), math.log(0.1))
    s5_b_re = nrm(ks[11], (DEPTH, G, N, C), (2.0 * C) ** -0.5)
    s5_b_im = nrm(ks[12], (DEPTH, G, N, C), (2.0 * C) ** -0.5)
    s5_c_re = nrm(ks[13], (DEPTH, G, C, N), (2.0 * N) ** -0.5)
    s5_c_im = nrm(ks[14], (DEPTH, G, C, N), (2.0 * N) ** -0.5)
    s5_d = nrm(ks[15], (DEPTH, G, C), 1.0)
    s5_glu_w = nrm(ks[16], (DEPTH, G, C, 2 * C), C ** -0.5)
    s5_glu_b = nrm(ks[17], (DEPTH, G, 2 * C), 0.01)
    w_out = nrm(ks[18], (DEPTH, D_MIX, D_MODEL), D_MIX ** -0.5)
    norm_ffn_g = 1.0 + nrm(ks[19], (DEPTH, D_MODEL), 0.02)
    router_group_w = nrm(ks[20], (DEPTH, D_MODEL, N_EXPERT_GROUPS), D_MODEL ** -0.5)
    router_group_b = nrm(ks[21], (DEPTH, N_EXPERT_GROUPS), 0.01)
    router_expert_w = nrm(ks[22], (DEPTH, D_MODEL, N_EXPERTS), D_MODEL ** -0.5)
    router_expert_b = nrm(ks[23], (DEPTH, N_EXPERTS), 0.01)
    expert_w_gate = nrm(ks[24], (DEPTH, N_EXPERTS, D_MODEL, D_EXPERT), D_MODEL ** -0.5)
    expert_w_up = nrm(ks[25], (DEPTH, N_EXPERTS, D_MODEL, D_EXPERT), D_MODEL ** -0.5)
    expert_w_down = nrm(ks[26], (DEPTH, N_EXPERTS, D_EXPERT, D_MODEL), D_EXPERT ** -0.5)
    norm_final_g = 1.0 + nrm(ks[27], (D_MODEL,), 0.02)
    return {"x": x, "norm_mix_g": norm_mix_g, "w_in": w_in, "conv_w": conv_w, "conv_b": conv_b,
            "i_bias": i_bias, "f_bias": f_bias, "mlstm_norm_g": mlstm_norm_g,
            "s5_lambda_re": s5_lambda_re, "s5_lambda_im": s5_lambda_im, "s5_log_dt": s5_log_dt,
            "s5_b_re": s5_b_re, "s5_b_im": s5_b_im, "s5_c_re": s5_c_re, "s5_c_im": s5_c_im,
            "s5_d": s5_d, "s5_glu_w": s5_glu_w, "s5_glu_b": s5_glu_b, "w_out": w_out,
            "norm_ffn_g": norm_ffn_g, "router_group_w": router_group_w, "router_group_b": router_group_b,
            "router_expert_w": router_expert_w, "router_expert_b": router_expert_b,
            "expert_w_gate": expert_w_gate, "expert_w_up": expert_w_up, "expert_w_down": expert_w_down,
            "norm_final_g": norm_final_g}


def reference(x, norm_mix_g, w_in, conv_w, conv_b, i_bias, f_bias, mlstm_norm_g,
              s5_lambda_re, s5_lambda_im, s5_log_dt, s5_b_re, s5_b_im, s5_c_re, s5_c_im,
              s5_d, s5_glu_w, s5_glu_b, w_out, norm_ffn_g, router_group_w, router_group_b,
              router_expert_w, router_expert_b, expert_w_gate, expert_w_up, expert_w_down,
              norm_final_g):
    for l in range(DEPTH):
        h = rmsnorm(x, norm_mix_g[l])
        mix = hybrid_mixer(h, w_in[l], conv_w[l], conv_b[l], i_bias[l], f_bias[l], mlstm_norm_g[l],
                           s5_lambda_re[l], s5_lambda_im[l], s5_log_dt[l], s5_b_re[l], s5_b_im[l],
                           s5_c_re[l], s5_c_im[l], s5_d[l], s5_glu_w[l], s5_glu_b[l], w_out[l])
        x = x + mix.astype(x.dtype)
        h = rmsnorm(x, norm_ffn_g[l])
        ffn = hierarchical_moe(h, router_group_w[l], router_group_b[l], router_expert_w[l], router_expert_b[l],
                               expert_w_gate[l], expert_w_up[l], expert_w_down[l])
        x = x + ffn.astype(x.dtype)
    return rmsnorm(x, norm_final_g)
```

```cpp
#include <hip/hip_runtime.h>
#include <math.h>

constexpr int T = 16384, L = 8192, D = 1024, NP = 2568;
constexpr int DM = 512, NH = 4, HD = 128;
constexpr int SG = 32, SC = 16, SN = 64;
constexpr int NE = 32, DE = 512;
constexpr float EPS = 1e-6f;

__device__ __forceinline__ float wave_sum(float v) {
#pragma unroll
    for (int o = 1; o < 64; o <<= 1) v += __shfl_xor(v, o);
    return v;
}
__device__ __forceinline__ float sigmoidf_(float x) { return 1.f / (1.f + expf(-x)); }
__device__ __forceinline__ float siluf_(float x) { return x / (1.f + expf(-x)); }
__device__ __forceinline__ float log_sigmoidf_(float x) { return fminf(x, 0.f) - log1pf(expf(-fabsf(x))); }
__device__ __forceinline__ float gelu_tanh(float x) { return 0.5f * x * (1.f + tanhf(0.7978845608028654f * (x + 0.044715f * x * x * x))); }

__global__ void k_rmsnorm(const float* __restrict__ x, const float* __restrict__ g, float* __restrict__ y) {
    const int row = blockIdx.x * 4 + (threadIdx.x >> 6), lane = threadIdx.x & 63;
    const float4* xr = (const float4*)(x + (size_t)row * D) + lane;
    float4 v[4]; float s = 0.f;
#pragma unroll
    for (int j = 0; j < 4; ++j) { v[j] = xr[64 * j]; s += v[j].x * v[j].x + v[j].y * v[j].y + v[j].z * v[j].z + v[j].w * v[j].w; }
    const float rs = rsqrtf(wave_sum(s) * (1.f / D) + EPS);
    float4* yr = (float4*)(y + (size_t)row * D) + lane; const float4* gr = (const float4*)g + lane;
#pragma unroll
    for (int j = 0; j < 4; ++j) { float4 gg = gr[64 * j]; yr[64 * j] = make_float4(v[j].x * rs * gg.x, v[j].y * rs * gg.y, v[j].z * rs * gg.z, v[j].w * rs * gg.w); }
}

__global__ void k_gemm(const float* __restrict__ A, int lda, const float* __restrict__ B, int ldb, float* __restrict__ C, int ldc,
                       int M, int N, int K, const float* __restrict__ R, int ldr) {
    __shared__ float As[16][68];
    __shared__ float Bs[16][68];
    const int tid = threadIdx.x, tx = tid & 15, ty = tid >> 4;
    const int m0 = blockIdx.y * 64, n0 = blockIdx.x * 64;
    float acc[4][4] = {};
    for (int k0 = 0; k0 < K; k0 += 16) {
        { const int r = tid >> 2, c = (tid & 3) * 4; const float4 a = *(const float4*)(A + (size_t)(m0 + r) * lda + k0 + c);
          As[c + 0][r] = a.x; As[c + 1][r] = a.y; As[c + 2][r] = a.z; As[c + 3][r] = a.w; }
        { const int r = tid >> 4, c = (tid & 15) * 4; float4 b = make_float4(0.f, 0.f, 0.f, 0.f);
          if (n0 + c < N) b = *(const float4*)(B + (size_t)(k0 + r) * ldb + n0 + c);
          *(float4*)&Bs[r][c] = b; }
        __syncthreads();
#pragma unroll
        for (int k = 0; k < 16; ++k) {
            const float4 a = *(const float4*)&As[k][ty * 4]; const float4 b = *(const float4*)&Bs[k][tx * 4];
            const float av[4] = {a.x, a.y, a.z, a.w}, bv[4] = {b.x, b.y, b.z, b.w};
#pragma unroll
            for (int i = 0; i < 4; ++i)
#pragma unroll
                for (int j = 0; j < 4; ++j) acc[i][j] += av[i] * bv[j];
        }
        __syncthreads();
    }
#pragma unroll
    for (int i = 0; i < 4; ++i) {
        const int m = m0 + ty * 4 + i, n = n0 + tx * 4;
        if (n < N) {
            float4 o = make_float4(acc[i][0], acc[i][1], acc[i][2], acc[i][3]);
            if (R) { const float4 r = *(const float4*)(R + (size_t)m * ldr + n); o.x += r.x; o.y += r.y; o.z += r.z; o.w += r.w; }
            *(float4*)(C + (size_t)m * ldc + n) = o;
        }
    }
}

__global__ void k_conv_silu(const float* __restrict__ proj, const float* __restrict__ cw, const float* __restrict__ cb, float* __restrict__ qk) {
    const size_t i = (size_t)blockIdx.x * 256 + threadIdx.x;
    const int t = (int)(i >> 10), c = (int)(i & 1023), tl = t & (L - 1);
    float a = cb[c];
#pragma unroll
    for (int j = 0; j < 4; ++j) { const int dt = j - 3; if (tl + dt >= 0) a += cw[j * 1024 + c] * proj[(size_t)(t + dt) * NP + c]; }
    a = siluf_(a);
    if (c >= 512) a *= 0.08838834764831845f;
    qk[i] = a;
}

__global__ void __launch_bounds__(256) k_mlstm_rec(const float* __restrict__ qk, const float* __restrict__ proj, const float* __restrict__ ib, const float* __restrict__ fb, float* __restrict__ hraw) {
    const int bh = blockIdx.x >> 3, vs = blockIdx.x & 7, b = bh >> 2, h = bh & 3;
    const int tid = threadIdx.x, vl = tid >> 4, ks = tid & 15, k0 = ks * 8, v = vs * 16 + vl;
    float c[8] = {}, n[8] = {}; float m = 0.f;
    const float ibias = ib[h], fbias = fb[h];
    const size_t t0 = (size_t)b * L;
    for (int t = 0; t < L; ++t) {
        const size_t tt = t0 + t;
        const float4 q0 = *(const float4*)(qk + tt * 1024 + h * 128 + k0), q1 = *(const float4*)(qk + tt * 1024 + h * 128 + k0 + 4);
        const float4 ka = *(const float4*)(qk + tt * 1024 + 512 + h * 128 + k0), kb = *(const float4*)(qk + tt * 1024 + 512 + h * 128 + k0 + 4);
        const float vv = proj[tt * NP + 1024 + h * 128 + v];
        const float li = proj[tt * NP + 2048 + h] + ibias;
        const float lf = log_sigmoidf_(proj[tt * NP + 2052 + h] + fbias);
        const float mn = fmaxf(lf + m, li);
        const float fd = expf(lf + m - mn), iw = expf(li - mn);
        m = mn;
        const float qv[8] = {q0.x, q0.y, q0.z, q0.w, q1.x, q1.y, q1.z, q1.w}, kv[8] = {ka.x, ka.y, ka.z, ka.w, kb.x, kb.y, kb.z, kb.w};
        float num = 0.f, den = 0.f;
#pragma unroll
        for (int i = 0; i < 8; ++i) { c[i] = fd * c[i] + iw * vv * kv[i]; n[i] = fd * n[i] + iw * kv[i]; num += c[i] * qv[i]; den += n[i] * qv[i]; }
#pragma unroll
        for (int o = 1; o < 16; o <<= 1) { num += __shfl_xor(num, o); den += __shfl_xor(den, o); }
        if (ks == 0) hraw[tt * 512 + h * 128 + v] = num / fmaxf(fabsf(den), expf(-mn));
    }
}

__global__ void k_mlstm_post(const float* __restrict__ hraw, const float* __restrict__ proj, const float* __restrict__ ng, float* __restrict__ merged) {
    const int w = blockIdx.x * 4 + (threadIdx.x >> 6), lane = threadIdx.x & 63;
    const int t = w >> 2, h = w & 3;
    const float a = hraw[(size_t)t * 512 + h * 128 + lane], bq = hraw[(size_t)t * 512 + h * 128 + 64 + lane];
    const float rs = rsqrtf(wave_sum(a * a + bq * bq) * (1.f / 128.f) + EPS);
    const int c0 = h * 128 + lane, c1 = c0 + 64;
    merged[(size_t)t * D + c0] = sigmoidf_(proj[(size_t)t * NP + 1536 + c0]) * (a * rs * ng[c0]);
    merged[(size_t)t * D + c1] = sigmoidf_(proj[(size_t)t * NP + 1536 + c1]) * (bq * rs * ng[c1]);
}

__global__ void k_s5_params(const float* lam_re, const float* lam_im, const float* log_dt, const float* b_re, const float* b_im, float* par, float* bbr, float* bbi) {
    const int i = blockIdx.x * 256 + threadIdx.x;
    if (i >= SG * SN) return;
    const int g = i / SN;
    const float lr = fminf(lam_re[i], -1e-4f), li = lam_im[i], dt = expf(log_dt[g]);
    const float mag = expf(lr * dt), ar = mag * cosf(li * dt), ai = mag * sinf(li * dt);
    const float den = lr * lr + li * li;
    const float cr = ((ar - 1.f) * lr + ai * li) / den, ci = (ai * lr - (ar - 1.f) * li) / den;
    par[2 * i] = ar; par[2 * i + 1] = ai;
    for (int h = 0; h < SC; ++h) { const float br = b_re[i * SC + h], bi = b_im[i * SC + h]; bbr[i * SC + h] = cr * br - ci * bi; bbi[i * SC + h] = cr * bi + ci * br; }
}

__global__ void __launch_bounds__(64) k_s5_scan(const float* __restrict__ proj, const float* __restrict__ par, const float* __restrict__ bbr, const float* __restrict__ bbi,
                          const float* __restrict__ c_re, const float* __restrict__ c_im, const float* __restrict__ dsk,
                          const float* __restrict__ glu_w, const float* __restrict__ glu_b, float* __restrict__ merged) {
    const int b = blockIdx.x >> 5, g = blockIdx.x & 31, lane = threadIdx.x;
    const int gi = g * SN + lane;
    const float ar = par[2 * gi], ai = par[2 * gi + 1];
    float br[16], bi[16], cr[16], ci[16];
#pragma unroll
    for (int h = 0; h < 16; ++h) { br[h] = bbr[gi * 16 + h]; bi[h] = bbi[gi * 16 + h]; cr[h] = c_re[(g * 16 + h) * SN + lane]; ci[h] = c_im[(g * 16 + h) * SN + lane]; }
    float gw[16]; const int cc = lane & 31;
#pragma unroll
    for (int h = 0; h < 16; ++h) gw[h] = glu_w[(g * 16 + h) * 32 + cc];
    const float gb = glu_b[g * 32 + cc];
    float dk[16];
#pragma unroll
    for (int h = 0; h < 16; ++h) dk[h] = dsk[g * 16 + h];
    float sr = 0.f, si = 0.f;
    for (int t = 0; t < L; ++t) {
        const size_t tt = (size_t)b * L + t;
        const float* up = proj + tt * NP + 2056 + g * 16;
        float u[16];
#pragma unroll
        for (int q = 0; q < 4; ++q) { const float4 x = *(const float4*)(up + 4 * q); u[4 * q] = x.x; u[4 * q + 1] = x.y; u[4 * q + 2] = x.z; u[4 * q + 3] = x.w; }
        float pr = 0.f, pi = 0.f;
#pragma unroll
        for (int h = 0; h < 16; ++h) { pr += u[h] * br[h]; pi += u[h] * bi[h]; }
        const float nr = ar * sr - ai * si + pr, ni = ar * si + ai * sr + pi;
        sr = nr; si = ni;
        float z = gb;
#pragma unroll
        for (int h = 0; h < 16; ++h) {
            float y = wave_sum(sr * cr[h] - si * ci[h]) + dk[h] * u[h];
            y = gelu_tanh(y);
            z += y * gw[h];
        }
        const float zo = __shfl(z, (lane & 15) + 16);
        if (lane < 16) merged[tt * D + 512 + g * 16 + lane] = z * sigmoidf_(zo);
    }
}

__global__ void __launch_bounds__(256) k_router(const float* __restrict__ x1, const float* __restrict__ g2, const float* __restrict__ rgw, const float* __restrict__ rgb,
                         const float* __restrict__ rew, const float* __restrict__ reb, float* __restrict__ rs2, int* __restrict__ tok_e, float* __restrict__ tok_w, int* __restrict__ cnt) {
    const int t = blockIdx.x * 4 + (threadIdx.x >> 6), lane = threadIdx.x & 63;
    float xv[16]; float s = 0.f;
#pragma unroll
    for (int j = 0; j < 16; ++j) { xv[j] = x1[(size_t)t * D + lane + 64 * j]; s += xv[j] * xv[j]; }
    const float rs = rsqrtf(wave_sum(s) * (1.f / D) + EPS);
#pragma unroll
    for (int j = 0; j < 16; ++j) xv[j] = xv[j] * rs * g2[lane + 64 * j];
    float gl[4];
#pragma unroll
    for (int c = 0; c < 4; ++c) { float a = 0.f;
#pragma unroll
        for (int j = 0; j < 16; ++j) a += xv[j] * rgw[(size_t)(lane + 64 * j) * 4 + c];
        gl[c] = wave_sum(a) + rgb[c]; }
    int gi = 0; float gm = gl[0];
#pragma unroll
    for (int c = 1; c < 4; ++c) if (gl[c] > gm) { gm = gl[c]; gi = c; }
    float gs = 0.f;
#pragma unroll
    for (int c = 0; c < 4; ++c) gs += expf(gl[c] - gm);
    const float gwt = 1.f / gs;
    float el[8];
#pragma unroll
    for (int c = 0; c < 8; ++c) { float a = 0.f;
#pragma unroll
        for (int j = 0; j < 16; ++j) a += xv[j] * rew[(size_t)(lane + 64 * j) * 32 + gi * 8 + c];
        el[c] = wave_sum(a) + reb[gi * 8 + c]; }
    int i0 = 0; float m0 = el[0];
#pragma unroll
    for (int c = 1; c < 8; ++c) if (el[c] > m0) { m0 = el[c]; i0 = c; }
    int i1 = -1; float m1 = -INFINITY;
#pragma unroll
    for (int c = 0; c < 8; ++c) if (c != i0 && el[c] > m1) { m1 = el[c]; i1 = c; }
    const float p1 = expf(m1 - m0);
    const float w0 = gwt / (1.f + p1), w1 = gwt * p1 / (1.f + p1);
    if (lane == 0) {
        rs2[t] = rs;
        const int e0 = gi * 8 + i0, e1 = gi * 8 + i1;
        tok_e[2 * t] = e0; tok_e[2 * t + 1] = e1; tok_w[2 * t] = w0; tok_w[2 * t + 1] = w1;
        atomicAdd(&cnt[e0], 1); atomicAdd(&cnt[e1], 1);
    }
}
__global__ void k_prefix(const int* cnt, int* off, int* fill) { if (threadIdx.x == 0) { int a = 0; for (int e = 0; e < NE; ++e) { off[e] = a; fill[e] = 0; a += cnt[e]; } } }
__global__ void k_assign(const int* __restrict__ tok_e, const int* __restrict__ off, int* __restrict__ fill, int* __restrict__ slot_tok, int* __restrict__ tok_slot) {
    const int i = blockIdx.x * 256 + threadIdx.x;
    const int e = tok_e[i]; const int pos = atomicAdd(&fill[e], 1); const int slot = off[e] + pos;
    slot_tok[slot] = i >> 1; tok_slot[i] = slot;
}

__global__ void __launch_bounds__(256) k_moe_gu(const float* __restrict__ x1, const float* __restrict__ rs2, const float* __restrict__ g2, const int* __restrict__ slot_tok, const int* __restrict__ off, const int* __restrict__ cnt,
                         const float* __restrict__ Wg, const float* __restrict__ Wu, float* __restrict__ H) {
    const int e = blockIdx.z, mt = blockIdx.y, n0 = blockIdx.x * 64;
    const int ce = cnt[e]; if (mt * 64 >= ce) return;
    const int s0 = off[e] + mt * 64, send = off[e] + ce;
    __shared__ float As[16][68]; __shared__ float Bg[16][68]; __shared__ float Bu[16][68];
    const int tid = threadIdx.x, tx = tid & 15, ty = tid >> 4;
    const float* wg = Wg + (size_t)e * D * DE; const float* wu = Wu + (size_t)e * D * DE;
    const int ar = tid >> 2, ac = (tid & 3) * 4;
    const int aslot = min(s0 + ar, send - 1); const int atok = slot_tok[aslot]; const float ars = rs2[atok];
    float accg[4][4] = {}, accu[4][4] = {};
    for (int k0 = 0; k0 < D; k0 += 16) {
        { const float4 a = *(const float4*)(x1 + (size_t)atok * D + k0 + ac); const float4 gg = *(const float4*)(g2 + k0 + ac);
          As[ac + 0][ar] = a.x * ars * gg.x; As[ac + 1][ar] = a.y * ars * gg.y; As[ac + 2][ar] = a.z * ars * gg.z; As[ac + 3][ar] = a.w * ars * gg.w; }
        { const int r = tid >> 4, c = (tid & 15) * 4;
          *(float4*)&Bg[r][c] = *(const float4*)(wg + (size_t)(k0 + r) * DE + n0 + c);
          *(float4*)&Bu[r][c] = *(const float4*)(wu + (size_t)(k0 + r) * DE + n0 + c); }
        __syncthreads();
#pragma unroll
        for (int k = 0; k < 16; ++k) {
            const float4 a = *(const float4*)&As[k][ty * 4]; const float4 bg = *(const float4*)&Bg[k][tx * 4]; const float4 bu = *(const float4*)&Bu[k][tx * 4];
            const float av[4] = {a.x, a.y, a.z, a.w}, gv[4] = {bg.x, bg.y, bg.z, bg.w}, uv[4] = {bu.x, bu.y, bu.z, bu.w};
#pragma unroll
            for (int i = 0; i < 4; ++i)
#pragma unroll
                for (int j = 0; j < 4; ++j) { accg[i][j] += av[i] * gv[j]; accu[i][j] += av[i] * uv[j]; }
        }
        __syncthreads();
    }
#pragma unroll
    for (int i = 0; i < 4; ++i) { const int slot = s0 + ty * 4 + i; if (slot < send) {
        float4 o = make_float4(siluf_(accg[i][0]) * accu[i][0], siluf_(accg[i][1]) * accu[i][1], siluf_(accg[i][2]) * accu[i][2], siluf_(accg[i][3]) * accu[i][3]);
        *(float4*)(H + (size_t)slot * DE + n0 + tx * 4) = o; } }
}
__global__ void k_moe_down(const float* __restrict__ H, const int* __restrict__ off, const int* __restrict__ cnt, const float* __restrict__ Wd, float* __restrict__ Y) {
    const int e = blockIdx.z, mt = blockIdx.y, n0 = blockIdx.x * 64;
    const int ce = cnt[e]; if (mt * 64 >= ce) return;
    const int s0 = off[e] + mt * 64, send = off[e] + ce;
    __shared__ float As[16][68]; __shared__ float Bs[16][68];
    const int tid = threadIdx.x, tx = tid & 15, ty = tid >> 4;
    const float* wd = Wd + (size_t)e * DE * D;
    const int ar = tid >> 2, ac = (tid & 3) * 4; const int aslot = min(s0 + ar, send - 1);
    float acc[4][4] = {};
    for (int k0 = 0; k0 < DE; k0 += 16) {
        { const float4 a = *(const float4*)(H + (size_t)aslot * DE + k0 + ac); As[ac + 0][ar] = a.x; As[ac + 1][ar] = a.y; As[ac + 2][ar] = a.z; As[ac + 3][ar] = a.w; }
        { const int r = tid >> 4, c = (tid & 15) * 4; *(float4*)&Bs[r][c] = *(const float4*)(wd + (size_t)(k0 + r) * D + n0 + c); }
        __syncthreads();
#pragma unroll
        for (int k = 0; k < 16; ++k) {
            const float4 a = *(const float4*)&As[k][ty * 4]; const float4 b = *(const float4*)&Bs[k][tx * 4];
            const float av[4] = {a.x, a.y, a.z, a.w}, bv[4] = {b.x, b.y, b.z, b.w};
#pragma unroll
            for (int i = 0; i < 4; ++i)
#pragma unroll
                for (int j = 0; j < 4; ++j) acc[i][j] += av[i] * bv[j];
        }
        __syncthreads();
    }
#pragma unroll
    for (int i = 0; i < 4; ++i) { const int slot = s0 + ty * 4 + i; if (slot < send)
        *(float4*)(Y + (size_t)slot * D + n0 + tx * 4) = make_float4(acc[i][0], acc[i][1], acc[i][2], acc[i][3]); }
}
__global__ void k_final(const float* __restrict__ x1, const float* __restrict__ Y, const int* __restrict__ tok_slot, const float* __restrict__ tok_w, const float* __restrict__ g, float* __restrict__ out) {
    const int t = blockIdx.x * 4 + (threadIdx.x >> 6), lane = threadIdx.x & 63;
    const int s0 = tok_slot[2 * t], s1 = tok_slot[2 * t + 1]; const float w0 = tok_w[2 * t], w1 = tok_w[2 * t + 1];
    float4 v[4]; float s = 0.f;
#pragma unroll
    for (int j = 0; j < 4; ++j) {
        const float4 a = ((const float4*)(x1 + (size_t)t * D) + lane)[64 * j], y0 = ((const float4*)(Y + (size_t)s0 * D) + lane)[64 * j], y1 = ((const float4*)(Y + (size_t)s1 * D) + lane)[64 * j];
        v[j] = make_float4(a.x + (w0 * y0.x + w1 * y1.x), a.y + (w0 * y0.y + w1 * y1.y), a.z + (w0 * y0.z + w1 * y1.z), a.w + (w0 * y0.w + w1 * y1.w));
        s += v[j].x * v[j].x + v[j].y * v[j].y + v[j].z * v[j].z + v[j].w * v[j].w; }
    const float rs = rsqrtf(wave_sum(s) * (1.f / D) + EPS);
#pragma unroll
    for (int j = 0; j < 4; ++j) { const float4 gg = ((const float4*)g + lane)[64 * j]; ((float4*)(out + (size_t)t * D) + lane)[64 * j] = make_float4(v[j].x * rs * gg.x, v[j].y * rs * gg.y, v[j].z * rs * gg.z, v[j].w * rs * gg.w); }
}

extern "C" void kernel_launch(void* const* d_in, const int* in_sizes, int n_in, void* d_out, int out_size, void* d_ws, size_t ws_size, hipStream_t stream) {
    const float* x = (const float*)d_in[0]; const float* g1 = (const float*)d_in[1]; const float* w_in = (const float*)d_in[2];
    const float* conv_w = (const float*)d_in[3]; const float* conv_b = (const float*)d_in[4]; const float* i_bias = (const float*)d_in[5]; const float* f_bias = (const float*)d_in[6];
    const float* mng = (const float*)d_in[7]; const float* lam_re = (const float*)d_in[8]; const float* lam_im = (const float*)d_in[9]; const float* log_dt = (const float*)d_in[10];
    const float* b_re = (const float*)d_in[11]; const float* b_im = (const float*)d_in[12]; const float* c_re = (const float*)d_in[13]; const float* c_im = (const float*)d_in[14];
    const float* s5d = (const float*)d_in[15]; const float* glu_w = (const float*)d_in[16]; const float* glu_b = (const float*)d_in[17]; const float* w_out = (const float*)d_in[18];
    const float* g2 = (const float*)d_in[19]; const float* rgw = (const float*)d_in[20]; const float* rgb = (const float*)d_in[21]; const float* rew = (const float*)d_in[22]; const float* reb = (const float*)d_in[23];
    const float* Wg = (const float*)d_in[24]; const float* Wu = (const float*)d_in[25]; const float* Wd = (const float*)d_in[26]; const float* gf = (const float*)d_in[27];
    float* out = (float*)d_out; char* ws = (char*)d_ws;
    const size_t MB = 1u << 20;
    float* R0 = (float*)(ws);
    float* R1 = (float*)(ws + 64 * MB);
    float* hraw = (float*)(ws + 226 * MB);
    char* sm = ws + 258 * MB;
    float* par = (float*)sm; float* bbr = (float*)(sm + 65536); float* bbi = (float*)(sm + 65536 + 262144);
    float* rs2 = (float*)(sm + 1 * MB); int* tok_e = (int*)(sm + 1 * MB + 65536); float* tok_w = (float*)(sm + 1 * MB + 65536 + 131072);
    int* tok_slot = (int*)(sm + 1 * MB + 65536 + 262144); int* slot_tok = (int*)(sm + 1 * MB + 65536 + 393216);
    int* cnt = (int*)(sm + 2 * MB - 4096); int* off = cnt + 64; int* fill = cnt + 128;
    float* merged = out;
    float* H = out;

    (void)hipMemsetAsync(cnt, 0, 1024, stream);
    k_rmsnorm<<<T / 4, 256, 0, stream>>>(x, g1, R0);
    k_gemm<<<dim3((NP + 63) / 64, T / 64), 256, 0, stream>>>(R0, D, w_in, NP, R1, NP, T, NP, D, nullptr, 0);
    k_conv_silu<<<T * 1024 / 256, 256, 0, stream>>>(R1, conv_w, conv_b, R0);
    k_mlstm_rec<<<64, 256, 0, stream>>>(R0, R1, i_bias, f_bias, hraw);
    k_mlstm_post<<<T, 256, 0, stream>>>(hraw, R1, mng, merged);
    k_s5_params<<<8, 256, 0, stream>>>(lam_re, lam_im, log_dt, b_re, b_im, par, bbr, bbi);
    k_s5_scan<<<64, 64, 0, stream>>>(R1, par, bbr, bbi, c_re, c_im, s5d, glu_w, glu_b, merged);
    k_gemm<<<dim3(D / 64, T / 64), 256, 0, stream>>>(merged, D, w_out, D, R0, D, T, D, D, x, D);
    k_router<<<T / 4, 256, 0, stream>>>(R0, g2, rgw, rgb, rew, reb, rs2, tok_e, tok_w, cnt);
    k_prefix<<<1, 64, 0, stream>>>(cnt, off, fill);
    k_assign<<<2 * T / 256, 256, 0, stream>>>(tok_e, off, fill, slot_tok, tok_slot);
    k_moe_gu<<<dim3(DE / 64, T / 64, NE), 256, 0, stream>>>(R0, rs2, g2, slot_tok, off, cnt, Wg, Wu, H);
    k_moe_down<<<dim3(D / 64, T / 64, NE), 256, 0, stream>>>(H, off, cnt, Wd, R1);
    k_final<<<T / 4, 256, 0, stream>>>(R0, R1, tok_slot, tok_w, gf, out);
}
```

```cpp
#include <hip/hip_runtime.h>
#include <math.h>
#include <stdint.h>

constexpr int T = 16384, L = 8192, D = 1024, NP = 2568;
constexpr int NH = 4, HD = 128;
constexpr int SG = 32, SC = 16, SN = 64;
constexpr int NE = 32, DE = 512;
constexpr float EPS = 1e-6f;
constexpr int LC = 32, NCH = T / LC;
constexpr int AGK = 640;

#define GAS __attribute__((address_space(1)))
#define LAS __attribute__((address_space(3)))
typedef unsigned short bf16;
typedef unsigned v4u __attribute__((ext_vector_type(4)));
typedef unsigned v2u __attribute__((ext_vector_type(2)));
typedef float f32x4 __attribute__((ext_vector_type(4)));
typedef float f32x2 __attribute__((ext_vector_type(2)));
typedef short bf16x8 __attribute__((ext_vector_type(8)));

__device__ __forceinline__ unsigned f2bf(float f) { unsigned u = __builtin_bit_cast(unsigned, f); return (u + 0x7fffu + ((u >> 16) & 1u)) >> 16; }
__device__ __forceinline__ unsigned pk2(float lo, float hi) { return f2bf(lo) | (f2bf(hi) << 16); }
__device__ __forceinline__ float bf2f(unsigned b) { return __builtin_bit_cast(float, b << 16); }
__device__ __forceinline__ float wave_sum(float v) {
#pragma unroll
    for (int o = 1; o < 64; o <<= 1) v += __shfl_xor(v, o);
    return v;
}
__device__ __forceinline__ float sigmoidf_(float x) { return 1.f / (1.f + __expf(-x)); }
__device__ __forceinline__ float siluf_(float x) { return x / (1.f + __expf(-x)); }
__device__ __forceinline__ float log_sigmoidf_(float x) { return fminf(x, 0.f) - log1pf(expf(-fabsf(x))); }
__device__ __forceinline__ float gelu_tanh(float x) { const float u = 0.7978845608028654f * (x + 0.044715f * x * x * x); return x / (1.f + __expf(-2.f * u)); }

constexpr size_t MiB = 1u << 20;
constexpr size_t WS_CTL = 0, CTL_ZERO_BYTES = 64 * 1024;
constexpr size_t WS_WIN = 1 * MiB;
constexpr size_t WS_WOUT = 6 * MiB;
constexpr size_t WS_TQ = 8 * MiB;
constexpr size_t WS_PG = 28 * MiB;
constexpr size_t WS_SMALL = 33 * MiB;
constexpr size_t WS_GATES = WS_SMALL;
constexpr size_t WS_RS2 = WS_SMALL + 512 * 1024;
constexpr size_t WS_TOKE = WS_RS2 + 64 * 1024;
constexpr size_t WS_TOKW = WS_TOKE + 128 * 1024;
constexpr size_t WS_TOKP = WS_TOKW + 128 * 1024;
constexpr size_t WS_LIST = WS_SMALL + 1 * MiB;
constexpr size_t WS_S5PAR = WS_SMALL + 3 * MiB;
constexpr size_t WS_MSC = WS_SMALL + 3 * MiB + 64 * 1024;
constexpr size_t WS_DN = WS_SMALL + 4 * MiB;
constexpr size_t WS_E = WS_SMALL + 5 * MiB;
constexpr size_t WS_XB = 40 * MiB;
constexpr size_t WS_QKVO = 72 * MiB;
constexpr size_t WS_DC = 136 * MiB;
constexpr size_t WS_WGU = 72 * MiB;
constexpr size_t WS_WD = 136 * MiB;
constexpr size_t WS_AG = 168 * MiB;
constexpr size_t WS_EE = 188 * MiB;
constexpr size_t WS_Y5 = 196 * MiB;
constexpr size_t WS_H = 168 * MiB;
constexpr size_t WS_Y = 201 * MiB;
constexpr size_t WS_END = 266 * MiB;
constexpr int CW_CNT = 1024;
constexpr int CW_BAR = 4096;

namespace pg8 {
typedef unsigned u32x4 __attribute__((ext_vector_type(4)));
constexpr int BM = 256, BK = 64, HALF = 128, HTB = HALF * BK * 2, STAGE_BYTES = 8 * HTB;
__host__ __device__ __forceinline__ int lds_byte(int r, int c) { const int st = (r >> 4) * 2 + (c >> 5), rr = r & 15, cc = c & 31, ob = rr * 64 + cc * 2; return st * 1024 + (ob ^ (((ob >> 9) & 1) << 5)); }
__host__ __device__ __forceinline__ void stage_rc(int b, int& R, int& C) { const int st = b / 1024, sb = b % 1024, swz = sb ^ (((sb >> 9) & 1) << 5); R = (st >> 1) * 16 + swz / 64; C = (st & 1) * 32 + (swz % 64) / 2; }
__host__ __device__ __forceinline__ int perm32(int rho) { const int n = rho >> 4, i = rho & 15; return 8 * (i >> 2) + 4 * n + (i & 3); }
__device__ __forceinline__ unsigned cvt_pk_bf16(float lo, float hi) { unsigned r; asm volatile("v_cvt_pk_bf16_f32 %0, %1, %2" : "=v"(r) : "v"(lo), "v"(hi)); return r; }

struct Unit { int pm, pn, e, rows, slot0, lidx; };

template <class Epi, class Sched, bool ALIGN_EPI = true>
__device__ __forceinline__ void gemm_phase(LAS unsigned char* lds, const Sched& S, const Epi& E) {
    const int tid = threadIdx.x, wid = __builtin_amdgcn_readfirstlane(tid >> 6), lane = tid & 63, wr = wid >> 2, wc = wid & 3, fr = lane & 15, fq = lane >> 4;
    const int K = S.K, nt = K / BK;
    int Rr[2], Cc[2];
    unsigned voffA[2][2], voffB[2], voffN[2][2];
#pragma unroll
    for (int i = 0; i < 2; ++i) { int R, C; stage_rc(tid * 16 + i * 8192, R, C); Rr[i] = R; Cc[i] = C; const int Rb = Epi::PERM ? ((R & ~31) + perm32(R & 31)) : R;
        voffB[i] = (unsigned)(Rb * S.ldb + C) * 2u; }
    const size_t kstep = (size_t)(BK * 2);
    const size_t hstepB = (size_t)HALF * S.ldb * 2;
    const unsigned ldsw = (unsigned)wid * 1024u;
    const int aoff = lds_byte(wr * 64 + fr, fq * 8), boff = lds_byte(wc * 32 + fr, fq * 8);
#define PG8_SA(b, h) (((b) * 2 + (h)) * HTB)
#define PG8_SB(b, h) ((4 + (b) * 2 + (h)) * HTB)
#define PG8_STAGE(bufoff, gbase, voff) do { _Pragma("unroll") for (int _i = 0; _i < 2; ++_i) \
        __builtin_amdgcn_global_load_lds((const unsigned*)((const char*)(gbase) + (voff)[_i]), (LAS unsigned*)(lds + (bufoff) + ldsw + _i * 8192), 16, 0, 0); } while (0)
#define PG8_LDA(dst, b, h) do { _Pragma("unroll") for (int m = 0; m < 4; ++m) _Pragma("unroll") for (int k = 0; k < 2; ++k) dst[m][k] = *(const LAS bf16x8*)(lds + PG8_SA(b, h) + aoff + m * 2048 + k * 1024); } while (0)
#define PG8_LDB(dst, b, h) do { _Pragma("unroll") for (int n = 0; n < 2; ++n) _Pragma("unroll") for (int k = 0; k < 2; ++k) dst[n][k] = *(const LAS bf16x8*)(lds + PG8_SB(b, h) + boff + n * 2048 + k * 1024); } while (0)
#define PG8_MMA(ai, bj, At, Bt) do { __builtin_amdgcn_s_setprio(1); _Pragma("unroll") for (int m = 0; m < 4; ++m) _Pragma("unroll") for (int n = 0; n < 2; ++n) _Pragma("unroll") for (int k = 0; k < 2; ++k) \
        acc[ai][bj][m][n] = __builtin_amdgcn_mfma_f32_16x16x32_bf16(Bt[n][k], At[m][k], acc[ai][bj][m][n], 0, 0, 0); __builtin_amdgcn_s_setprio(0); } while (0)
#define PG8_WAIT_V(n) asm volatile("s_waitcnt vmcnt(" #n ")" ::: "memory")
#define PG8_WAIT_L(n) asm volatile("s_waitcnt lgkmcnt(" #n ")" ::: "memory")
#define PG8_BAR __builtin_amdgcn_s_barrier()
#define PG8_SCHED __builtin_amdgcn_sched_barrier(0)
#define PG8_AOFF(dst, u) do { _Pragma("unroll") for (int _h = 0; _h < 2; ++_h) _Pragma("unroll") for (int _i = 0; _i < 2; ++_i) \
        dst[_h][_i] = (unsigned)(((size_t)S.a_row(u, _h * HALF + Rr[_i]) * S.lda + Cc[_i]) * 2u); } while (0)
    Unit cur, nxt; int ui = 0;
    if (!S.next(0, cur)) return;
    f32x4 acc[2][2][4][2];
#pragma unroll
    for (int a = 0; a < 2; ++a)
#pragma unroll
        for (int b = 0; b < 2; ++b)
#pragma unroll
            for (int m = 0; m < 4; ++m)
#pragma unroll
                for (int n = 0; n < 2; ++n) acc[a][b][m][n] = (f32x4){0.f, 0.f, 0.f, 0.f};
    bf16x8 At[4][2], B0[2][2], B1[2][2];
    const char* cA = S.a_ptr(cur); const char* cB = S.b_ptr(cur);
    PG8_AOFF(voffA, cur);
    PG8_STAGE(PG8_SB(0, 0), cB, voffB); PG8_STAGE(PG8_SB(0, 1), cB + hstepB, voffB); PG8_STAGE(PG8_SA(0, 0), cA, voffA[0]); PG8_STAGE(PG8_SA(0, 1), cA, voffA[1]);
    if (wr == 1) PG8_BAR;
    PG8_WAIT_V(2); PG8_BAR;
    PG8_STAGE(PG8_SB(1, 0), cB + kstep, voffB); PG8_STAGE(PG8_SA(1, 0), cA + kstep, voffA[0]); PG8_STAGE(PG8_SB(1, 1), cB + hstepB + kstep, voffB);
    PG8_WAIT_V(6); PG8_BAR;
    for (;;) {
        const bool has_next = S.next(ui + 1, nxt);
        const char* nA = has_next ? S.a_ptr(nxt) : cA; const char* nB = has_next ? S.b_ptr(nxt) : cB;
        if (has_next) { PG8_AOFF(voffN, nxt); } else {
#pragma unroll
            for (int h = 0; h < 2; ++h)
#pragma unroll
                for (int i = 0; i < 2; ++i) voffN[h][i] = voffA[h][i]; }
        for (int t = 0; t < nt; t += 2) {
            const bool last = (t == nt - 2);
            const char* a1 = cA + (size_t)(t + 1) * kstep;
            const char* a2 = last ? nA : cA + (size_t)(t + 2) * kstep; const char* b2 = last ? nB : cB + (size_t)(t + 2) * kstep;
            const char* a3 = a2 + kstep; const char* b3 = b2 + kstep;
            unsigned vo2[2][2];
#pragma unroll
            for (int h = 0; h < 2; ++h)
#pragma unroll
                for (int i = 0; i < 2; ++i) vo2[h][i] = last ? voffN[h][i] : voffA[h][i];
            PG8_LDB(B0, 0, 0); PG8_LDB(B1, 0, 1); PG8_SCHED; PG8_LDA(At, 0, 0); PG8_STAGE(PG8_SA(1, 1), a1, voffA[1]);
            PG8_WAIT_V(8); PG8_WAIT_L(0); PG8_BAR; PG8_MMA(0, 0, At, B0); PG8_MMA(0, 1, At, B1); PG8_BAR; PG8_SCHED;
            PG8_LDA(At, 0, 1); PG8_STAGE(PG8_SB(0, 0), b2, voffB); PG8_STAGE(PG8_SB(0, 1), b2 + hstepB, voffB); PG8_STAGE(PG8_SA(0, 0), a2, vo2[0]);
            PG8_WAIT_V(8); PG8_WAIT_L(0); PG8_BAR; PG8_MMA(1, 0, At, B0); PG8_MMA(1, 1, At, B1); PG8_BAR; PG8_SCHED;
            PG8_LDB(B0, 1, 0); PG8_LDB(B1, 1, 1); PG8_SCHED; PG8_LDA(At, 1, 0); PG8_STAGE(PG8_SA(0, 1), a2, vo2[1]);
            PG8_WAIT_V(8); PG8_WAIT_L(0); PG8_BAR; PG8_MMA(0, 0, At, B0); PG8_MMA(0, 1, At, B1); PG8_BAR; PG8_SCHED;
            PG8_LDA(At, 1, 1); PG8_STAGE(PG8_SB(1, 0), b3, voffB); PG8_STAGE(PG8_SB(1, 1), b3 + hstepB, voffB); PG8_STAGE(PG8_SA(1, 0), a3, vo2[0]);
            PG8_WAIT_V(8); PG8_WAIT_L(0); PG8_BAR; PG8_MMA(1, 0, At, B0); PG8_MMA(1, 1, At, B1); PG8_BAR; PG8_SCHED;
        }
        if constexpr (ALIGN_EPI) { if (wr == 0) PG8_BAR; }
        E(acc, cur, wr, wc, fr, fq);
        if (!has_next) break;
#pragma unroll
        for (int a = 0; a < 2; ++a)
#pragma unroll
            for (int b = 0; b < 2; ++b)
#pragma unroll
                for (int m = 0; m < 4; ++m)
#pragma unroll
                    for (int n = 0; n < 2; ++n) acc[a][b][m][n] = (f32x4){0.f, 0.f, 0.f, 0.f};
        cur = nxt; cA = nA; cB = nB; ++ui;
#pragma unroll
        for (int h = 0; h < 2; ++h)
#pragma unroll
            for (int i = 0; i < 2; ++i) voffA[h][i] = voffN[h][i];
        if constexpr (ALIGN_EPI) { if (wr == 1) PG8_BAR; }
    }
    PG8_WAIT_V(0);
    if constexpr (!ALIGN_EPI) { if (wr == 0) PG8_BAR; }
    PG8_BAR;
#undef PG8_SA
#undef PG8_SB
#undef PG8_STAGE
#undef PG8_LDA
#undef PG8_LDB
#undef PG8_MMA
#undef PG8_WAIT_V
#undef PG8_WAIT_L
#undef PG8_BAR
#undef PG8_SCHED
#undef PG8_AOFF
}
}

#define XB_TMO      128
#define XB_XCNT(j)  (256  + 64 * (j))
#define XB_XSUB(j)  (1280 + 64 * (j))
#define XB_XGEN(j)  (2304 + 64 * (j))
#define XB_TOP      3328
#define XB_TOPGEN   3392
#define XCD_BAR_WORDS 3456
#define XB_SPIN_CAP (1u << 20)
__device__ __forceinline__ unsigned xb_ld(unsigned* p)              { return __hip_atomic_load(p, __ATOMIC_RELAXED, __HIP_MEMORY_SCOPE_AGENT); }
__device__ __forceinline__ unsigned xb_add(unsigned* p, unsigned v) { return __hip_atomic_fetch_add(p, v, __ATOMIC_RELAXED, __HIP_MEMORY_SCOPE_AGENT); }
__device__ __forceinline__ unsigned xb_xcc_id() { return (unsigned)__builtin_amdgcn_s_getreg((3 << 11) | 20) & 0xFu; }
#define XB_SPIN(cond, bar) do { unsigned _sp = 0; while (cond) { __builtin_amdgcn_s_sleep(1); \
    if ((++_sp & 255u) == 0u) { if (xb_ld(&(bar)[XB_TMO])) break; if (_sp > XB_SPIN_CAP) { atomicAdd(&(bar)[XB_TMO], 1u); break; } } } } while (0)
struct XcdBarrier { unsigned* bar; unsigned x; volatile LAS unsigned* st; };
__device__ __forceinline__ XcdBarrier xcd_barrier_post(unsigned* bar, volatile LAS unsigned* st) {
    XcdBarrier b; b.bar = bar; b.x = xb_xcc_id(); b.st = st;
    if (threadIdx.x == 0) (void)xb_add(&bar[XB_XCNT(b.x)], 1u);
    return b;
}
__device__ __forceinline__ void xcd_barrier_complete(unsigned* bar, unsigned x, unsigned& nloc, unsigned& nx) {
    const unsigned G = gridDim.x * gridDim.y * gridDim.z;
    unsigned sum, cnt, mine, sp = 0u;
    for (;;) {
        sum = 0u; cnt = 0u; mine = 0u;
#pragma unroll
        for (unsigned j = 0; j < 16; ++j) { const unsigned c = xb_ld(&bar[XB_XCNT(j)]); sum += c; cnt += (c > 0u) ? 1u : 0u; mine = (j == x) ? c : mine; }
        if (sum == G) break;
        __builtin_amdgcn_s_sleep(1);
        if ((++sp & 255u) == 0u) { if (xb_ld(&bar[XB_TMO])) break; if (sp > XB_SPIN_CAP) { atomicAdd(&bar[XB_TMO], 1u); break; } }
    }
    nloc = mine > 0u ? mine : 1u; nx = cnt > 0u ? cnt : 1u;
}
__device__ __forceinline__ void xcd_barrier(const XcdBarrier& b) {
    asm volatile("s_waitcnt vmcnt(0)" ::: "memory");
    __syncthreads();
    if (threadIdx.x == 0) {
        unsigned* bar = b.bar;
        __builtin_amdgcn_s_waitcnt(0);
        unsigned nloc = b.st[0], nx = b.st[1];
        if (nloc == 0u) { xcd_barrier_complete(bar, b.x, nloc, nx); b.st[0] = nloc; b.st[1] = nx; }
        const unsigned old = xb_add(&bar[XB_XSUB(b.x)], 1u);
        const unsigned gen = old / nloc;
        if (old + 1u == (gen + 1u) * nloc) {
            __builtin_amdgcn_fence(__ATOMIC_RELEASE, "agent");
            asm volatile("s_waitcnt vmcnt(0)" ::: "memory");
            const unsigned og = xb_add(&bar[XB_TOP], 1u);
            const unsigned tg = og / nx;
            if (og + 1u == (tg + 1u) * nx) xb_add(&bar[XB_TOPGEN], 1u);
            else XB_SPIN(xb_ld(&bar[XB_TOPGEN]) == tg, bar);
            __builtin_amdgcn_fence(__ATOMIC_ACQUIRE, "agent");
            xb_add(&bar[XB_XGEN(b.x)], 1u);
            asm volatile("s_waitcnt vmcnt(0)" ::: "memory");
        } else {
            XB_SPIN(xb_ld(&bar[XB_XGEN(b.x)]) == gen, bar);
            __builtin_amdgcn_fence(__ATOMIC_ACQUIRE, "agent");
            asm volatile("s_waitcnt vmcnt(0)" ::: "memory");
        }
    }
    __syncthreads();
}

constexpr int NWAVES = 8, NTHR = 512;
constexpr int RING_BYTES = 131072;
constexpr int LDS_AUX = RING_BYTES;
constexpr int LDS_AUX_BYTES = 12288;
constexpr int MISC_OFF = LDS_AUX + LDS_AUX_BYTES;
constexpr int LDS_BYTES = MISC_OFF + 256;

struct Args {
    const float* in[28]; float* out; unsigned char* ws; int ph_lo, ph_hi;
};
struct Frame {
    LAS unsigned char* lds; volatile LAS unsigned* MISC; unsigned* ctl;
    int tid, lane, wave, vcu, G;
    unsigned char* ws;
};

__device__ __forceinline__ void transpose_item(const float* W, int ldw, int k0, int scol0, bf16* WT, int ldt, int drow0, const float* ks, LAS float* scr, int lane) {
#pragma unroll 8
    for (int i = 0; i < 32; ++i) { const int kk = 2 * i + (lane >> 5); float v = W[(size_t)(k0 + kk) * ldw + scol0 + (lane & 31)]; if (ks) v *= ks[k0 + kk]; scr[kk * 33 + (lane & 31)] = v; }
    asm volatile("s_waitcnt lgkmcnt(0)" ::: "memory");
    const int c = lane & 7;
#pragma unroll
    for (int j = 0; j < 4; ++j) { const int n = (lane >> 3) + 8 * j; const LAS float* s = scr + (8 * c) * 33 + n;
        v4u o; o.x = pk2(s[0 * 33], s[1 * 33]); o.y = pk2(s[2 * 33], s[3 * 33]); o.z = pk2(s[4 * 33], s[5 * 33]); o.w = pk2(s[6 * 33], s[7 * 33]);
        *(v4u*)(WT + (size_t)(drow0 + n) * ldt + k0 + 8 * c) = o; }
    asm volatile("s_waitcnt lgkmcnt(0)" ::: "memory");
}

struct DenseSched {
    static constexpr int NXCD = 8, WGM = 8;
    const bf16* A; const bf16* Bt; int K, lda, ldb, nM, nN, nwg, G, c;
    __device__ void init(const bf16* A_, const bf16* Bt_, int M, int N, int K_, int lda_, int ldb_, int G_, int c_) { A = A_; Bt = Bt_; K = K_; lda = lda_; ldb = ldb_; nM = M / 256; nN = N / 256; nwg = nM * nN; G = G_; c = c_; }
    __device__ __forceinline__ bool next(int i, pg8::Unit& u) const {
        const long Lx = (long)i * G + c; if (Lx >= nwg) return false;
        int wgid = (int)Lx; { const int q = nwg / NXCD, r = nwg % NXCD, xcd = wgid % NXCD, off = wgid / NXCD; wgid = (xcd < r ? xcd * (q + 1) : r * (q + 1) + (xcd - r) * q) + off; }
        const int nig = WGM * nN, gid = wgid / nig, fm = gid * WGM, gsz = (nM - fm) < WGM ? (nM - fm) : WGM;
        u.pm = fm + ((wgid % nig) % gsz); u.pn = (wgid % nig) / gsz; u.e = 0; u.rows = 256; u.slot0 = u.pm * 256; u.lidx = i; return true;
    }
    __device__ __forceinline__ const char* a_ptr(const pg8::Unit&) const { return (const char*)A; }
    __device__ __forceinline__ const char* b_ptr(const pg8::Unit& u) const { return (const char*)(Bt + (size_t)u.pn * 256 * ldb); }
    __device__ __forceinline__ int a_row(const pg8::Unit& u, int r) const { return u.pm * 256 + r; }
};

constexpr int MOE_MAXU = 4;
struct MoeSched {
    const bf16* A; const bf16* Bt; int K, lda, ldb, G, c; size_t bstride;
    const LAS int* toff; const LAS int* soff; const LAS int* tokl;
    int nunits; bool gather;
    __device__ __forceinline__ bool next(int i, pg8::Unit& u) const {
        const int Lx = i * G + c; if (Lx >= nunits) return false;
        const int mtg = Lx >> 2; u.pn = Lx & 3;
        int e = 0;
#pragma unroll 1
        for (int j = 0; j < NE; ++j) if (toff[j + 1] <= mtg) e = j + 1;
        u.e = e; const int mt = mtg - toff[e]; u.pm = mt; const int ce = soff[e + 1] - soff[e];
        u.rows = min(256, ce - mt * 256); u.slot0 = soff[e] + mt * 256; u.lidx = i; return true;
    }
    __device__ __forceinline__ const char* a_ptr(const pg8::Unit&) const { return (const char*)A; }
    __device__ __forceinline__ const char* b_ptr(const pg8::Unit& u) const { return (const char*)(Bt + (size_t)u.e * bstride + (size_t)u.pn * 256 * ldb); }
    __device__ __forceinline__ int a_row(const pg8::Unit& u, int r) const { return gather ? tokl[u.lidx * 256 + r] : (u.slot0 + r); }
};

struct EpiInProj {
    static constexpr bool PERM = true;
    bf16* qkvo; bf16* ag;
    __device__ __forceinline__ void operator()(const f32x4 (&acc)[2][2][4][2], const pg8::Unit& u, int wr, int wc, int fr, int fq) const {
        const int row0 = u.pm * 256 + wr * 64 + fr; const int colt = u.pn * 256 + wc * 32 + 8 * fq;
#pragma unroll
        for (int ai = 0; ai < 2; ++ai)
#pragma unroll
            for (int m = 0; m < 4; ++m) { const int row = row0 + ai * 128 + m * 16;
#pragma unroll
                for (int bj = 0; bj < 2; ++bj) { const f32x4 v0 = acc[ai][bj][m][0], v1 = acc[ai][bj][m][1];
                    v4u w; w.x = pg8::cvt_pk_bf16(v0[0], v0[1]); w.y = pg8::cvt_pk_bf16(v0[2], v0[3]); w.z = pg8::cvt_pk_bf16(v1[0], v1[1]); w.w = pg8::cvt_pk_bf16(v1[2], v1[3]);
                    const int col = colt + bj * 128;
                    if (u.pn < 8) { *(v4u*)(qkvo + (size_t)(col >> 9) * T * 512 + (size_t)row * 512 + (col & 511)) = w; }
                    else { const int cu = col - 2048, g = cu >> 4, h0 = cu & 15; *(v4u*)(ag + ((size_t)g * NCH + (row >> 5)) * AGK + (row & 31) * 16 + h0) = w; } } }
    }
};
struct EpiResF32 {
    static constexpr bool PERM = false;
    const float* base; float* out;
    __device__ __forceinline__ void operator()(const f32x4 (&acc)[2][2][4][2], const pg8::Unit& u, int wr, int wc, int fr, int fq) const {
        const int row0 = u.pm * 256 + wr * 64 + fr, col0 = u.pn * 256 + wc * 32 + 4 * fq;
#pragma unroll
        for (int ai = 0; ai < 2; ++ai)
#pragma unroll
            for (int m = 0; m < 4; ++m) { const size_t off = (size_t)(row0 + ai * 128 + m * 16) * D + col0;
#pragma unroll
                for (int bj = 0; bj < 2; ++bj)
#pragma unroll
                    for (int n = 0; n < 2; ++n) { const f32x4 bs = *(const f32x4*)(base + off + bj * 128 + n * 16); *(f32x4*)(out + off + bj * 128 + n * 16) = bs + acc[ai][bj][m][n]; }
                asm volatile("" ::: "memory"); }
    }
};
struct EpiGateUp {
    static constexpr bool PERM = true;
    bf16* H;
    __device__ __forceinline__ void operator()(const f32x4 (&acc)[2][2][4][2], const pg8::Unit& u, int wr, int wc, int fr, int fq) const {
        const int r0 = wr * 64 + fr; const int col = u.pn * 128 + wc * 32 + 8 * fq;
#pragma unroll
        for (int ai = 0; ai < 2; ++ai)
#pragma unroll
            for (int m = 0; m < 4; ++m) { const int r = r0 + ai * 128 + m * 16;
                float o[8];
#pragma unroll
                for (int n = 0; n < 2; ++n)
#pragma unroll
                    for (int j = 0; j < 4; ++j) o[4 * n + j] = siluf_(acc[ai][0][m][n][j]) * acc[ai][1][m][n][j];
                v4u w; w.x = pg8::cvt_pk_bf16(o[0], o[1]); w.y = pg8::cvt_pk_bf16(o[2], o[3]); w.z = pg8::cvt_pk_bf16(o[4], o[5]); w.w = pg8::cvt_pk_bf16(o[6], o[7]);
                if (r < u.rows) *(v4u*)(H + (size_t)(u.slot0 + r) * DE + col) = w; }
    }
};
struct EpiDown {
    static constexpr bool PERM = true;
    bf16* Y;
    __device__ __forceinline__ void operator()(const f32x4 (&acc)[2][2][4][2], const pg8::Unit& u, int wr, int wc, int fr, int fq) const {
        const int r0 = wr * 64 + fr; const int col = u.pn * 256 + wc * 32 + 8 * fq;
#pragma unroll
        for (int ai = 0; ai < 2; ++ai)
#pragma unroll
            for (int m = 0; m < 4; ++m) { const int r = r0 + ai * 128 + m * 16;
#pragma unroll
                for (int bj = 0; bj < 2; ++bj) { const f32x4 v0 = acc[ai][bj][m][0], v1 = acc[ai][bj][m][1];
                    v4u w; w.x = pg8::cvt_pk_bf16(v0[0], v0[1]); w.y = pg8::cvt_pk_bf16(v0[2], v0[3]); w.z = pg8::cvt_pk_bf16(v1[0], v1[1]); w.w = pg8::cvt_pk_bf16(v1[2], v1[3]);
                    if (r < u.rows) *(v4u*)(Y + (size_t)(u.slot0 + r) * D + col + bj * 128) = w; } }
    }
};


typedef short s16x4 __attribute__((ext_vector_type(4)));
typedef short v4i16_t __attribute__((ext_vector_type(4)));
typedef float f32x16 __attribute__((ext_vector_type(16)));
__device__ __forceinline__ unsigned off_b(unsigned row, unsigned ch) { return 256u * row + 16u * (ch ^ (((row & 3) << 2) | ((row >> 2) & 3))); }
__device__ __forceinline__ s16x4 vtr(const LAS unsigned char* p) { return __builtin_bit_cast(s16x4, __builtin_amdgcn_ds_read_tr16_b64_v4i16((LAS v4i16_t*)p)); }
__device__ __forceinline__ unsigned tr_addr(unsigned row_base, unsigned c, unsigned lane) { const unsigned q = (lane & 15) >> 2, p = lane & 3; return off_b(row_base + q, 2 * c + (p >> 1)) + 8 * (p & 1); }
__device__ __forceinline__ bf16x8 cat4(s16x4 lo, s16x4 hi) { bf16x8 r; r[0] = lo[0]; r[1] = lo[1]; r[2] = lo[2]; r[3] = lo[3]; r[4] = hi[0]; r[5] = hi[1]; r[6] = hi[2]; r[7] = hi[3]; return r; }
__device__ __forceinline__ float wave_max(float v) {
#pragma unroll
    for (int o = 1; o < 64; o <<= 1) v = fmaxf(v, __shfl_xor(v, o));
    return v;
}
__device__ __forceinline__ void chunk_gates(const float* gates, int t0, int h, int lane, float& bcs, float& g) {
    const float li = gates[(size_t)(t0 + lane) * 8 + h], lf = gates[(size_t)(t0 + lane) * 8 + 4 + h];
    bcs = lf;
#pragma unroll
    for (int o = 1; o < 64; o <<= 1) { const float tv = __shfl_up(bcs, o); if (lane >= o) bcs += tv; }
    g = li - bcs;
}
__device__ __forceinline__ void conv4x8(const bf16* src, int tl0, const float* cw, const float* cb, float scale, v4u (&outp)[4]) {
    v4u raw[7];
#pragma unroll
    for (int i = 0; i < 7; ++i) { raw[i] = (v4u){0u, 0u, 0u, 0u}; if (tl0 - 3 + i >= 0) raw[i] = *(const v4u*)(src + (ptrdiff_t)(i - 3) * 512); }
    float w[4][8], bb[8];
#pragma unroll
    for (int j = 0; j < 4; ++j) { const f32x4 a = *(const f32x4*)(cw + j * 1024), b = *(const f32x4*)(cw + j * 1024 + 4); w[j][0] = a.x; w[j][1] = a.y; w[j][2] = a.z; w[j][3] = a.w; w[j][4] = b.x; w[j][5] = b.y; w[j][6] = b.z; w[j][7] = b.w; }
    { const f32x4 a = *(const f32x4*)cb, b = *(const f32x4*)(cb + 4); bb[0] = a.x; bb[1] = a.y; bb[2] = a.z; bb[3] = a.w; bb[4] = b.x; bb[5] = b.y; bb[6] = b.z; bb[7] = b.w; }
#pragma unroll
    for (int r = 0; r < 4; ++r) {
        float o[8];
#pragma unroll
        for (int e = 0; e < 8; ++e) { float a = bb[e];
#pragma unroll
            for (int j = 0; j < 4; ++j) { const unsigned d = raw[r + j][e >> 1]; a += w[j][e] * bf2f((e & 1) ? (d >> 16) : (d & 0xffffu)); }
            o[e] = siluf_(a) * scale; }
        outp[r] = (v4u){pk2(o[0], o[1]), pk2(o[2], o[3]), pk2(o[4], o[5]), pk2(o[6], o[7])};
    }
}

__device__ __forceinline__ void mlstm_a_pair(const Frame& F, int pair, const bf16* qkvo, const float* gates, const float* conv_w, const float* conv_b, bf16* dC, float* dn, float* msc) {
    const int hb = F.wave >> 2, w4 = F.wave & 3, tid4 = F.tid & 255, lane = F.lane, g4 = lane >> 4;
    const int unit = 2 * pair + hb, bh = unit >> 7, c = unit & 127, b = bh >> 2, h = bh & 3, t0 = b * L + c * 64;
    LAS unsigned char* Kimg = F.lds + hb * 65536; LAS unsigned char* Vimg = Kimg + 16384;
    float bcs, g; chunk_gates(gates, t0, h, lane, bcs, g);
    const float gmax = wave_max(g), wgt = __expf(g - gmax), bl = __shfl(bcs, 63);
    if (w4 == 0 && lane == 0) { msc[unit * 4 + 0] = bl + gmax; msc[unit * 4 + 1] = bl; }
    const int d8 = tid4 & 15, rg = tid4 >> 4;
    { v4u kc[4]; conv4x8(qkvo + (size_t)1 * T * 512 + (size_t)(t0 + 4 * rg) * 512 + h * 128 + 8 * d8, c * 64 + 4 * rg, conv_w + 512 + h * 128 + 8 * d8, conv_b + 512 + h * 128 + 8 * d8, 0.08838834764831845f, kc);
#pragma unroll
      for (int r = 0; r < 4; ++r) { const float ws = __shfl(wgt, 4 * rg + r);
          v4u o;
#pragma unroll
          for (int q = 0; q < 4; ++q) o[q] = pk2(bf2f(kc[r][q] & 0xffffu) * ws, bf2f(kc[r][q] >> 16) * ws);
          *(LAS v4u*)(Kimg + off_b(4 * rg + r, d8)) = o; }
#pragma unroll
      for (int r = 0; r < 4; ++r) *(LAS v4u*)(Vimg + off_b(4 * rg + r, d8)) = *(const v4u*)(qkvo + (size_t)2 * T * 512 + (size_t)(t0 + 4 * rg + r) * 512 + h * 128 + 8 * d8); }
    __syncthreads();
    f32x4 acc[2][8], accn[2];
#pragma unroll
    for (int a = 0; a < 2; ++a) { accn[a] = (f32x4){0.f, 0.f, 0.f, 0.f};
#pragma unroll
        for (int n = 0; n < 8; ++n) acc[a][n] = (f32x4){0.f, 0.f, 0.f, 0.f}; }
    bf16x8 ones; { const short o = ((lane & 15) == 0) ? (short)0x3F80 : (short)0;
#pragma unroll
        for (int j = 0; j < 8; ++j) ones[j] = o; }
#pragma unroll
    for (int ks = 0; ks < 2; ++ks) {
        bf16x8 a[2];
#pragma unroll
        for (int m2 = 0; m2 < 2; ++m2) a[m2] = cat4(vtr(Kimg + tr_addr(32 * ks + 8 * g4, 2 * w4 + m2, lane)), vtr(Kimg + tr_addr(32 * ks + 8 * g4 + 4, 2 * w4 + m2, lane)));
#pragma unroll
        for (int n = 0; n < 8; ++n) { const bf16x8 bv = cat4(vtr(Vimg + tr_addr(32 * ks + 8 * g4, n, lane)), vtr(Vimg + tr_addr(32 * ks + 8 * g4 + 4, n, lane)));
#pragma unroll
            for (int m2 = 0; m2 < 2; ++m2) acc[m2][n] = __builtin_amdgcn_mfma_f32_16x16x32_bf16(a[m2], bv, acc[m2][n], 0, 0, 0); }
#pragma unroll
        for (int m2 = 0; m2 < 2; ++m2) accn[m2] = __builtin_amdgcn_mfma_f32_16x16x32_bf16(a[m2], ones, accn[m2], 0, 0, 0);
    }
#pragma unroll
    for (int m2 = 0; m2 < 2; ++m2) { const int k0 = 16 * (2 * w4 + m2) + 4 * g4;
#pragma unroll
        for (int n = 0; n < 8; ++n) { const int v = 16 * n + (lane & 15); *(v2u*)(dC + ((size_t)unit * 128 + v) * 128 + k0) = (v2u){pk2(acc[m2][n][0], acc[m2][n][1]), pk2(acc[m2][n][2], acc[m2][n][3])}; }
        if ((lane & 15) == 0) *(f32x4*)(dn + (size_t)unit * 128 + k0) = accn[m2]; }
    __syncthreads();
}

__device__ __forceinline__ void mlstm_b(const Frame& F, bf16* dC, float* dn, float* msc) {
    LAS float* sa = (LAS float*)(F.lds); LAS float* sb = sa + 128; LAS float* fd = sa + 256; LAS float* iw = sa + 384; LAS float* mm = sa + 512;
    for (int e0 = F.vcu * NTHR; e0 < 8 * 16384; e0 += F.G * NTHR) {
        const int e = e0 + F.tid, bh = e0 >> 14, idx = e & 16383;
        if (F.tid < 128) { sa[F.tid] = msc[(bh * 128 + F.tid) * 4 + 0]; sb[F.tid] = msc[(bh * 128 + F.tid) * 4 + 1]; }
        __syncthreads();
        if (F.tid == 0) { float m = 0.f; for (int c = 0; c < 128; ++c) { const float mn = fmaxf(sb[c] + m, sa[c]); fd[c] = __expf(sb[c] + m - mn); iw[c] = __expf(sa[c] - mn); mm[c] = m; m = mn; } }
        __syncthreads();
        bf16* p = dC + (size_t)bh * 128 * 16384 + idx;
        float C = 0.f;
#pragma unroll 8
        for (int c = 0; c < 128; ++c) { const float d = bf2f(p[(size_t)c * 16384]); p[(size_t)c * 16384] = (bf16)f2bf(C); C = fd[c] * C + iw[c] * d; }
        if (idx < 128) { float* q = dn + (size_t)bh * 128 * 128 + idx; float nn = 0.f;
#pragma unroll 8
            for (int c = 0; c < 128; ++c) { const float d = q[c * 128]; q[c * 128] = nn; nn = fd[c] * nn + iw[c] * d; } }
        if (idx == 0) for (int c = 0; c < 128; ++c) msc[(bh * 128 + c) * 4 + 2] = mm[c];
        __syncthreads();
    }
}

__device__ __forceinline__ void mlstm_c_pair(const Frame& F, int pair, const bf16* qkvo, const float* gates, const float* conv_w, const float* conv_b, const bf16* Cst, const float* nst, const float* msc, const float* ng, bf16* merged) {
    const int hb = F.wave >> 2, w4 = F.wave & 3, tid4 = F.tid & 255, lane = F.lane, g4 = lane >> 4, l15 = lane & 15;
    const int unit = 2 * pair + hb, bh = unit >> 7, c = unit & 127, b = bh >> 2, h = bh & 3, t0 = b * L + c * 64;
    LAS unsigned char* Kimg = F.lds + hb * 65536; LAS unsigned char* Vimg = Kimg + 16384; LAS unsigned char* Cimg = Kimg + 32768; LAS unsigned char* Qimg = Cimg;
    LAS float* gl = (LAS float*)(F.lds + LDS_AUX + hb * 4096); LAS float* bcl = gl + 64; LAS float* nl = gl + 128;
    float bcs, g; chunk_gates(gates, t0, h, lane, bcs, g);
    if (w4 == 0) { gl[lane] = g; bcl[lane] = bcs; }
    const float mc = msc[unit * 4 + 2];
    const int d8 = tid4 & 15, rg = tid4 >> 4;
    { v4u kc[4]; conv4x8(qkvo + (size_t)1 * T * 512 + (size_t)(t0 + 4 * rg) * 512 + h * 128 + 8 * d8, c * 64 + 4 * rg, conv_w + 512 + h * 128 + 8 * d8, conv_b + 512 + h * 128 + 8 * d8, 0.08838834764831845f, kc);
#pragma unroll
      for (int r = 0; r < 4; ++r) *(LAS v4u*)(Kimg + off_b(4 * rg + r, d8)) = kc[r]; }
    { v4u qc[4]; conv4x8(qkvo + (size_t)(t0 + 4 * rg) * 512 + h * 128 + 8 * d8, c * 64 + 4 * rg, conv_w + h * 128 + 8 * d8, conv_b + h * 128 + 8 * d8, 1.0f, qc);
#pragma unroll
      for (int r = 0; r < 4; ++r) *(LAS v4u*)(Qimg + off_b(4 * rg + r, d8)) = qc[r]; }
#pragma unroll
    for (int r = 0; r < 4; ++r) *(LAS v4u*)(Vimg + off_b(4 * rg + r, d8)) = *(const v4u*)(qkvo + (size_t)2 * T * 512 + (size_t)(t0 + 4 * rg + r) * 512 + h * 128 + 8 * d8);
    if (tid4 < 128) nl[tid4] = nst[(size_t)unit * 128 + tid4];
    v4u creg[8];
#pragma unroll
    for (int i = 0; i < 8; ++i) creg[i] = *(const v4u*)(Cst + (size_t)unit * 16384 + (size_t)(tid4 + 256 * i) * 8);
    __syncthreads();
    const int jl = 16 * w4 + l15;
    bf16x8 qf[4];
#pragma unroll
    for (int kk = 0; kk < 4; ++kk) qf[kk] = *(const LAS bf16x8*)(Qimg + off_b(jl, 4 * kk + g4));
    float M = mc;
    for (int s = 0; s < 64; ++s) { const float gs = gl[s]; M = (s <= jl) ? fmaxf(M, gs) : M; }
    const float winter = __expf(mc - M);
    v2u sb[4];
#pragma unroll
    for (int st = 0; st < 4; ++st) {
        f32x4 a4 = (f32x4){0.f, 0.f, 0.f, 0.f};
#pragma unroll
        for (int kk = 0; kk < 4; ++kk) { const bf16x8 ka = *(const LAS bf16x8*)(Kimg + off_b(16 * st + l15, 4 * kk + g4)); a4 = __builtin_amdgcn_mfma_f32_16x16x32_bf16(ka, qf[kk], a4, 0, 0, 0); }
        const f32x4 gs = *(const LAS f32x4*)(gl + 16 * st + 4 * g4);
        float vv[4];
#pragma unroll
        for (int r = 0; r < 4; ++r) { const int s = 16 * st + 4 * g4 + r; vv[r] = (s <= jl) ? a4[r] * __expf(gs[r] - M) : 0.f; }
        sb[st] = (v2u){pk2(vv[0], vv[1]), pk2(vv[2], vv[3])};
    }
    __syncthreads();
#pragma unroll
    for (int i = 0; i < 8; ++i) { const int q = tid4 + 256 * i; *(LAS v4u*)(Cimg + off_b(q >> 4, q & 15)) = creg[i]; }
    __syncthreads();
    f32x4 ai[9], ae[9];
#pragma unroll
    for (int vt = 0; vt < 9; ++vt) { ai[vt] = (f32x4){0.f, 0.f, 0.f, 0.f}; ae[vt] = (f32x4){0.f, 0.f, 0.f, 0.f}; }
    bf16x8 ones; { const short o = (l15 == 0) ? (short)0x3F80 : (short)0;
#pragma unroll
        for (int j = 0; j < 8; ++j) ones[j] = o; }
#pragma unroll
    for (int ks = 0; ks < 2; ++ks) {
        bf16x8 bs; { const v4u t4 = (v4u){sb[2 * ks].x, sb[2 * ks].y, sb[2 * ks + 1].x, sb[2 * ks + 1].y}; bs = __builtin_bit_cast(bf16x8, t4); }
#pragma unroll
        for (int vt = 0; vt < 8; ++vt) { const bf16x8 va = cat4(vtr(Vimg + tr_addr(32 * ks + 4 * g4, vt, lane)), vtr(Vimg + tr_addr(32 * ks + 16 + 4 * g4, vt, lane)));
            ai[vt] = __builtin_amdgcn_mfma_f32_16x16x32_bf16(va, bs, ai[vt], 0, 0, 0); }
        ai[8] = __builtin_amdgcn_mfma_f32_16x16x32_bf16(ones, bs, ai[8], 0, 0, 0);
    }
#pragma unroll
    for (int kk = 0; kk < 4; ++kk) {
#pragma unroll
        for (int vt = 0; vt < 8; ++vt) { const bf16x8 ca = *(const LAS bf16x8*)(Cimg + off_b(16 * vt + l15, 4 * kk + g4)); ae[vt] = __builtin_amdgcn_mfma_f32_16x16x32_bf16(ca, qf[kk], ae[vt], 0, 0, 0); }
        bf16x8 na; { const f32x4 n0 = *(const LAS f32x4*)(nl + 32 * kk + 8 * g4), n1 = *(const LAS f32x4*)(nl + 32 * kk + 8 * g4 + 4);
            const v4u t4 = (l15 == 0) ? (v4u){pk2(n0.x, n0.y), pk2(n0.z, n0.w), pk2(n1.x, n1.y), pk2(n1.z, n1.w)} : (v4u){0u, 0u, 0u, 0u}; na = __builtin_bit_cast(bf16x8, t4); }
        ae[8] = __builtin_amdgcn_mfma_f32_16x16x32_bf16(na, qf[kk], ae[8], 0, 0, 0);
    }
    float den = ai[8][0] + winter * ae[8][0];
    den = __shfl(den, l15);
    const float mrow = bcl[jl] + M;
    const float inv = 1.f / fmaxf(fabsf(den), __expf(-mrow));
    float hv[8][4]; float ss = 0.f;
#pragma unroll
    for (int vt = 0; vt < 8; ++vt)
#pragma unroll
        for (int r = 0; r < 4; ++r) { const float x = (ai[vt][r] + winter * ae[vt][r]) * inv; hv[vt][r] = x; ss += x * x; }
    ss += __shfl_xor(ss, 16); ss += __shfl_xor(ss, 32);
    const float rs = rsqrtf(ss * (1.f / 128.f) + EPS);
    const size_t tok = (size_t)(t0 + jl);
#pragma unroll
    for (int vt = 0; vt < 8; ++vt) { const int col = h * 128 + 16 * vt + 4 * g4;
        const v2u ov = *(const v2u*)(qkvo + (size_t)3 * T * 512 + tok * 512 + col); const f32x4 gg = *(const f32x4*)(ng + col);
        const float o0 = sigmoidf_(bf2f(ov.x & 0xffffu)) * (hv[vt][0] * rs * gg.x), o1 = sigmoidf_(bf2f(ov.x >> 16)) * (hv[vt][1] * rs * gg.y);
        const float o2 = sigmoidf_(bf2f(ov.y & 0xffffu)) * (hv[vt][2] * rs * gg.z), o3 = sigmoidf_(bf2f(ov.y >> 16)) * (hv[vt][3] * rs * gg.w);
        *(v2u*)(merged + tok * D + col) = (v2u){pk2(o0, o1), pk2(o2, o3)}; }
    __syncthreads();
}

__device__ __forceinline__ void s5_gen(const Frame& F, int g, const float* lam_re, const float* lam_im, const float* log_dt, const float* b_re, const float* b_im, const float* c_re, const float* c_im, const float* dsk, bf16* TQ, bf16* PG, float* a32) {
    LAS float* apr = (LAS float*)F.lds; LAS float* api = apr + 33 * 64; LAS float* bbr = api + 33 * 64; LAS float* bbi = bbr + 1024; LAS float* cre = bbi + 1024; LAS float* cim = cre + 1024; LAS float* ktab = cim + 1024;
    const int tid = F.tid;
    if (tid < 64) { const int n = tid, gi = g * SN + n;
        const float lr = fminf(lam_re[gi], -1e-4f), li = lam_im[gi], dt = expf(log_dt[g]);
        for (int p = 0; p <= 32; ++p) { const float mag = expf((float)p * lr * dt); float sn, cs; sincosf((float)p * li * dt, &sn, &cs); apr[p * 64 + n] = mag * cs; api[p * 64 + n] = mag * sn; }
        const float ar = apr[64 + n], ai = api[64 + n], den = lr * lr + li * li;
        const float cr = ((ar - 1.f) * lr + ai * li) / den, ci = (ai * lr - (ar - 1.f) * li) / den;
        for (int hh = 0; hh < 16; ++hh) { const float br = b_re[gi * 16 + hh], bi = b_im[gi * 16 + hh]; bbr[n * 16 + hh] = cr * br - ci * bi; bbi[n * 16 + hh] = cr * bi + ci * br; }
        a32[gi * 2] = apr[32 * 64 + n]; a32[gi * 2 + 1] = api[32 * 64 + n]; }
    for (int i = tid; i < 1024; i += NTHR) { cre[i] = c_re[g * 1024 + i]; cim[i] = c_im[g * 1024 + i]; }
    __syncthreads();
    for (int i = tid; i < 32 * 256; i += NTHR) { const int tau = i >> 8, hh = (i >> 4) & 15, hp = i & 15; float a = 0.f;
        for (int n = 0; n < 64; ++n) { const float xr = cre[hh * 64 + n] * apr[tau * 64 + n] - cim[hh * 64 + n] * api[tau * 64 + n], xi = cre[hh * 64 + n] * api[tau * 64 + n] + cim[hh * 64 + n] * apr[tau * 64 + n];
            a += xr * bbr[n * 16 + hp] - xi * bbi[n * 16 + hp]; }
        if (tau == 0 && hh == hp) a += dsk[g * 16 + hh];
        ktab[i] = a; }
    __syncthreads();
    bf16* tq = TQ + (size_t)g * 512 * AGK; bf16* pg = PG + (size_t)g * 128 * 512;
    for (int i = tid; i < 512 * 80; i += NTHR) { const int row = i / 80, k0 = (i % 80) * 8, j = row >> 4, hh = row & 15; float o[8];
        if (k0 < 512) { const int ii = k0 >> 4, hp0 = k0 & 15, tau = j - ii;
#pragma unroll
            for (int q = 0; q < 8; ++q) o[q] = (tau >= 0) ? ktab[tau * 256 + hh * 16 + hp0 + q] : 0.f; }
        else { const int im = (k0 >= 576), n0 = (k0 - 512) & 63;
#pragma unroll
            for (int q = 0; q < 8; ++q) { const int n = n0 + q; const float pr = apr[(j + 1) * 64 + n], pi = api[(j + 1) * 64 + n], cr = cre[hh * 64 + n], ci = cim[hh * 64 + n];
                o[q] = im ? -(cr * pi + ci * pr) : (cr * pr - ci * pi); } }
        *(v4u*)(tq + (size_t)row * AGK + k0) = (v4u){pk2(o[0], o[1]), pk2(o[2], o[3]), pk2(o[4], o[5]), pk2(o[6], o[7])}; }
    for (int i = tid; i < 128 * 64; i += NTHR) { const int row = i >> 6, k0 = (i & 63) * 8, im = row >> 6, n = row & 63, ii = k0 >> 4, hp0 = k0 & 15; float o[8];
        const float pr = apr[(31 - ii) * 64 + n], pi = api[(31 - ii) * 64 + n];
#pragma unroll
        for (int q = 0; q < 8; ++q) { const float br = bbr[n * 16 + hp0 + q], bi = bbi[n * 16 + hp0 + q]; o[q] = im ? (pr * bi + pi * br) : (pr * br - pi * bi); }
        *(v4u*)(pg + (size_t)row * 512 + k0) = (v4u){pk2(o[0], o[1]), pk2(o[2], o[3]), pk2(o[4], o[5]), pk2(o[6], o[7])}; }
    __syncthreads();
}

__device__ __forceinline__ void s5_scan(const Frame& F, int bg, const float* E, const float* a32, bf16* ag) {
    const int b = bg >> 5, g = bg & 31, n = F.lane, w = F.wave;
    LAS float* ex = (LAS float*)F.lds;
    const float ar = a32[(g * 64 + n) * 2], ai = a32[(g * 64 + n) * 2 + 1];
    const size_t ch0 = (size_t)g * NCH + b * 256 + w * 32;
    float er[32], ei[32];
#pragma unroll
    for (int c = 0; c < 32; ++c) { er[c] = E[(ch0 + c) * 128 + n]; ei[c] = E[(ch0 + c) * 128 + 64 + n]; }
    float sr = 0.f, si = 0.f;
#pragma unroll
    for (int c = 0; c < 32; ++c) { const float nr = ar * sr - ai * si + er[c], ni = ar * si + ai * sr + ei[c]; sr = nr; si = ni; }
    ex[(w * 64 + n) * 2] = sr; ex[(w * 64 + n) * 2 + 1] = si;
    float pr = ar, pi = ai;
#pragma unroll
    for (int q = 0; q < 5; ++q) { const float t = pr * pr - pi * pi; pi = 2.f * pr * pi; pr = t; }
    __syncthreads();
    sr = 0.f; si = 0.f;
    for (int ww = 0; ww < w; ++ww) { const float xr = ex[(ww * 64 + n) * 2], xi = ex[(ww * 64 + n) * 2 + 1]; const float nr = pr * sr - pi * si + xr, ni = pr * si + pi * sr + xi; sr = nr; si = ni; }
#pragma unroll
    for (int c = 0; c < 32; ++c) { bf16* row = ag + (ch0 + c) * AGK + 512; row[n] = (bf16)f2bf(sr); row[64 + n] = (bf16)f2bf(si);
        const float nr = ar * sr - ai * si + er[c], ni = ar * si + ai * sr + ei[c]; sr = nr; si = ni; }
    __syncthreads();
}

__device__ __forceinline__ void s5_post(const Frame& F, int gw, int NGW, const bf16* y5, const float* glu_w, const float* glu_b, bf16* merged) {
    const int lane = F.lane, l31 = lane & 31, half = lane >> 5;
    for (int g = gw & 31; g < 32; g += 32) {
        bf16x8 af; { float a[8];
#pragma unroll
            for (int j = 0; j < 8; ++j) a[j] = glu_w[(size_t)(g * 16 + 8 * half + j) * 32 + l31];
            const v4u t4 = (v4u){pk2(a[0], a[1]), pk2(a[2], a[3]), pk2(a[4], a[5]), pk2(a[6], a[7])}; af = __builtin_bit_cast(bf16x8, t4); }
        f32x16 bias;
#pragma unroll
        for (int r = 0; r < 16; ++r) bias[r] = glu_b[g * 32 + (r & 3) + 8 * (r >> 2) + 4 * half];
        for (int tb = gw >> 5; tb < T / 32; tb += NGW >> 5) {
            const size_t tok = (size_t)tb * 32 + l31;
            const v4u yv = *(const v4u*)(y5 + tok * 512 + g * 16 + 8 * half);
            float y[8];
#pragma unroll
            for (int q = 0; q < 4; ++q) { y[2 * q] = gelu_tanh(bf2f(yv[q] & 0xffffu)); y[2 * q + 1] = gelu_tanh(bf2f(yv[q] >> 16)); }
            const v4u t4 = (v4u){pk2(y[0], y[1]), pk2(y[2], y[3]), pk2(y[4], y[5]), pk2(y[6], y[7])};
            const f32x16 z = __builtin_amdgcn_mfma_f32_32x32x16_bf16(af, __builtin_bit_cast(bf16x8, t4), bias, 0, 0, 0);
            float o[8];
#pragma unroll
            for (int r = 0; r < 8; ++r) o[r] = z[r] * sigmoidf_(z[r + 8]);
            bf16* dst = merged + tok * D + 512 + g * 16 + 4 * half;
            *(v2u*)dst = (v2u){pk2(o[0], o[1]), pk2(o[2], o[3])};
            *(v2u*)(dst + 8) = (v2u){pk2(o[4], o[5]), pk2(o[6], o[7])};
        }
    }
}

struct S5ESched {
    const bf16* AG; const bf16* PG; int K, lda, ldb, G, c;
    __device__ __forceinline__ bool next(int i, pg8::Unit& u) const { const int Lx = i * G + c; if (Lx >= 64) return false; u.e = Lx >> 1; u.pm = Lx & 1; u.pn = 0; u.rows = 256; u.slot0 = 0; u.lidx = i; return true; }
    __device__ __forceinline__ const char* a_ptr(const pg8::Unit& u) const { return (const char*)(AG + (size_t)u.e * NCH * AGK); }
    __device__ __forceinline__ const char* b_ptr(const pg8::Unit& u) const { return (const char*)(PG + (size_t)u.e * 128 * 512); }
    __device__ __forceinline__ int a_row(const pg8::Unit& u, int r) const { return u.pm * 256 + r; }
};
struct EpiS5E {
    static constexpr bool PERM = false;
    float* E;
    __device__ __forceinline__ void operator()(const f32x4 (&acc)[2][2][4][2], const pg8::Unit& u, int wr, int wc, int fr, int fq) const {
#pragma unroll
        for (int ai = 0; ai < 2; ++ai)
#pragma unroll
            for (int m = 0; m < 4; ++m) { const int chunk = u.pm * 256 + ai * 128 + wr * 64 + m * 16 + fr;
#pragma unroll
                for (int n = 0; n < 2; ++n) *(f32x4*)(E + ((size_t)u.e * NCH + chunk) * 128 + wc * 32 + 16 * n + 4 * fq) = acc[ai][0][m][n]; }
    }
};
struct S5YSched {
    const bf16* AG; const bf16* TQ; int K, lda, ldb, G, c;
    __device__ __forceinline__ bool next(int i, pg8::Unit& u) const { const int Lx = i * G + c; if (Lx >= 128) return false; u.e = Lx >> 2; u.pm = (Lx >> 1) & 1; u.pn = Lx & 1; u.rows = 256; u.slot0 = 0; u.lidx = i; return true; }
    __device__ __forceinline__ const char* a_ptr(const pg8::Unit& u) const { return (const char*)(AG + (size_t)u.e * NCH * AGK); }
    __device__ __forceinline__ const char* b_ptr(const pg8::Unit& u) const { return (const char*)(TQ + (size_t)u.e * 512 * AGK + (size_t)u.pn * 256 * AGK); }
    __device__ __forceinline__ int a_row(const pg8::Unit& u, int r) const { return u.pm * 256 + r; }
};
struct EpiS5Y {
    static constexpr bool PERM = true;
    bf16* y5;
    __device__ __forceinline__ void operator()(const f32x4 (&acc)[2][2][4][2], const pg8::Unit& u, int wr, int wc, int fr, int fq) const {
#pragma unroll
        for (int ai = 0; ai < 2; ++ai)
#pragma unroll
            for (int m = 0; m < 4; ++m) { const int chunk = u.pm * 256 + ai * 128 + wr * 64 + m * 16 + fr;
#pragma unroll
                for (int bj = 0; bj < 2; ++bj) { const f32x4 v0 = acc[ai][bj][m][0], v1 = acc[ai][bj][m][1];
                    v4u w; w.x = pg8::cvt_pk_bf16(v0[0], v0[1]); w.y = pg8::cvt_pk_bf16(v0[2], v0[3]); w.z = pg8::cvt_pk_bf16(v1[0], v1[1]); w.w = pg8::cvt_pk_bf16(v1[2], v1[3]);
                    const int np = u.pn * 256 + bj * 128 + wc * 32 + 8 * fq, j = np >> 4, h0 = np & 15;
                    *(v4u*)(y5 + ((size_t)chunk * 32 + j) * 512 + u.e * 16 + h0) = w; } }
    }
};

__global__ void __launch_bounds__(NTHR, 2) mk_fwd(Args args) {
    extern __shared__ __attribute__((aligned(16))) unsigned char lds_raw[];
    Frame F;
    F.lds = (LAS unsigned char*)lds_raw; F.MISC = (volatile LAS unsigned*)(F.lds + MISC_OFF);
    F.tid = threadIdx.x; F.lane = F.tid & 63; F.wave = __builtin_amdgcn_readfirstlane(F.tid >> 6);
    F.G = gridDim.x; { const int bx = blockIdx.x; F.vcu = (F.G % 8 == 0) ? (bx % 8) * (F.G / 8) + bx / 8 : bx; }
    F.ws = args.ws; F.ctl = (unsigned*)(args.ws + WS_CTL);
    unsigned char* ws = args.ws;
    const int lo = args.ph_lo, hi = args.ph_hi;
    for (int u = F.tid; u < 64; u += NTHR) ((LAS unsigned*)(F.lds + MISC_OFF))[u] = 0u;
    __syncthreads();
    XcdBarrier bar = xcd_barrier_post(F.ctl + CW_BAR, F.MISC + 8);
#define IN(k) (lo <= (k) && (k) < hi)
#define SEAM(k) do { if (IN(k) && IN((k) + 1)) xcd_barrier(bar); } while (0)
    const int gw = F.vcu * NWAVES + F.wave, NGW = F.G * NWAVES;
    const float* x = args.in[0];
    bf16* xb = (bf16*)(ws + WS_XB);
    float* gates = (float*)(ws + WS_GATES);

    if (IN(0)) {
        const float* g1 = args.in[1]; const float* w_in = args.in[2]; const float* w_out = args.in[18];
        LAS float* wg = (LAS float*)(F.lds);
        for (int i = F.tid; i < 1024 * 8; i += NTHR) { const int k = i >> 3, c = i & 7; wg[i] = w_in[(size_t)k * NP + 2048 + c] * g1[k]; }
        __syncthreads();
        const float* ib = args.in[5]; const float* fb = args.in[6];
        for (int m = gw; m < T; m += NGW) {
            const GAS f32x4* xr = (const GAS f32x4*)(x + (size_t)m * D) + F.lane;
            f32x4 v[4]; float s = 0.f;
#pragma unroll
            for (int j = 0; j < 4; ++j) { v[j] = xr[64 * j]; s += (v[j].x * v[j].x + v[j].y * v[j].y) + (v[j].z * v[j].z + v[j].w * v[j].w); }
            const float rs = rsqrtf(wave_sum(s) * (1.f / D) + EPS);
            float d[8] = {};
#pragma unroll
            for (int j = 0; j < 4; ++j) {
#pragma unroll
                for (int q = 0; q < 4; ++q) { const int k = 4 * F.lane + 256 * j + q; const f32x4 w0 = *(const LAS f32x4*)(wg + k * 8), w1 = *(const LAS f32x4*)(wg + k * 8 + 4); const float xv = v[j][q] * rs;
                    d[0] += xv * w0.x; d[1] += xv * w0.y; d[2] += xv * w0.z; d[3] += xv * w0.w; d[4] += xv * w1.x; d[5] += xv * w1.y; d[6] += xv * w1.z; d[7] += xv * w1.w; } }
#pragma unroll
            for (int c = 0; c < 8; ++c) d[c] = wave_sum(d[c]);
            GAS unsigned long long* o8 = (GAS unsigned long long*)(xb + (size_t)m * D) + F.lane;
#pragma unroll
            for (int j = 0; j < 4; ++j) o8[64 * j] = (unsigned long long)pk2(v[j].x * rs, v[j].y * rs) | ((unsigned long long)pk2(v[j].z * rs, v[j].w * rs) << 32);
            if (F.lane < 8) { const int c = F.lane; float val = 0.f;
#pragma unroll
                for (int q = 0; q < 8; ++q) val = (c == q) ? d[q] : val;
                val = (c < 4) ? (val + ib[c & 3]) : log_sigmoidf_(val + fb[c & 3]); gates[(size_t)m * 8 + c] = val; }
        }
        __syncthreads();
        LAS float* scr = (LAS float*)(F.lds + F.wave * 16384);
        constexpr int I_IN = (D / 64) * (2560 / 32), I_OUT = (D / 64) * (D / 32);
        for (int it = gw; it < I_IN + I_OUT; it += NGW) {
            if (it < I_IN) { const int kb = it / 80, nb = it % 80, n0 = nb * 32; transpose_item(w_in, NP, kb * 64, n0 < 2048 ? n0 : n0 + 8, (bf16*)(ws + WS_WIN), D, n0, g1, scr, F.lane); }
            else { const int r = it - I_IN, kb = r / 32, nb = r % 32; transpose_item(w_out, D, kb * 64, nb * 32, (bf16*)(ws + WS_WOUT), D, nb * 32, nullptr, scr, F.lane); }
        }
    }
    if (IN(0)) { __syncthreads();
        for (int g = F.vcu; g < SG; g += F.G) s5_gen(F, g, args.in[8], args.in[9], args.in[10], args.in[11], args.in[12], args.in[13], args.in[14], args.in[15], (bf16*)(ws + WS_TQ), (bf16*)(ws + WS_PG), (float*)(ws + WS_S5PAR)); }
    SEAM(0);
    if (IN(1)) {
        DenseSched S; S.init(xb, (const bf16*)(ws + WS_WIN), T, 2560, D, D, D, F.G, (int)blockIdx.x);
        EpiInProj E{(bf16*)(ws + WS_QKVO), (bf16*)(ws + WS_AG)};
        pg8::gemm_phase<EpiInProj, DenseSched>(F.lds, S, E);
    }
    SEAM(1);
    if (IN(2)) {
        { S5ESched S; S.AG = (const bf16*)(ws + WS_AG); S.PG = (const bf16*)(ws + WS_PG); S.K = 512; S.lda = AGK; S.ldb = 512; S.G = F.G; S.c = (int)blockIdx.x;
          EpiS5E E{(float*)(ws + WS_EE)};
          pg8::gemm_phase<EpiS5E, S5ESched>(F.lds, S, E); }
        __syncthreads();
        for (int p = F.vcu; p < 512; p += F.G) mlstm_a_pair(F, p, (const bf16*)(ws + WS_QKVO), gates, args.in[3], args.in[4], (bf16*)(ws + WS_DC), (float*)(ws + WS_DN), (float*)(ws + WS_MSC));
    }
    SEAM(2);
    if (IN(3)) {
        for (int bg = F.vcu; bg < 64; bg += F.G) s5_scan(F, bg, (const float*)(ws + WS_EE), (const float*)(ws + WS_S5PAR), (bf16*)(ws + WS_AG));
        __syncthreads();
        mlstm_b(F, (bf16*)(ws + WS_DC), (float*)(ws + WS_DN), (float*)(ws + WS_MSC));
    }
    SEAM(3);
    if (IN(4)) {
        { S5YSched S; S.AG = (const bf16*)(ws + WS_AG); S.TQ = (const bf16*)(ws + WS_TQ); S.K = AGK; S.lda = AGK; S.ldb = AGK; S.G = F.G; S.c = (int)blockIdx.x;
          EpiS5Y E{(bf16*)(ws + WS_Y5)};
          pg8::gemm_phase<EpiS5Y, S5YSched>(F.lds, S, E); }
        __syncthreads();
        for (int p = F.vcu; p < 512; p += F.G) mlstm_c_pair(F, p, (const bf16*)(ws + WS_QKVO), gates, args.in[3], args.in[4], (const bf16*)(ws + WS_DC), (const float*)(ws + WS_DN), (const float*)(ws + WS_MSC), args.in[7], xb);
    }
    SEAM(4);
    if (IN(5)) s5_post(F, gw, NGW, (const bf16*)(ws + WS_Y5), args.in[16], args.in[17], xb);
    SEAM(5);
    if (IN(6)) {
        DenseSched S; S.init(xb  , (const bf16*)(ws + WS_WOUT), T, D, D, D, D, F.G, (int)blockIdx.x);
        EpiResF32 E{x, args.out};
        pg8::gemm_phase<EpiResF32, DenseSched>(F.lds, S, E);
    }
    SEAM(6);
    if (IN(7)) {
        const float* g2 = args.in[19]; const float* rgw = args.in[20]; const float* rgb = args.in[21]; const float* rew = args.in[22]; const float* reb = args.in[23];
        float* rs2o = (float*)(ws + WS_RS2); int* tok_e = (int*)(ws + WS_TOKE); float* tok_w = (float*)(ws + WS_TOKW); int* tok_p = (int*)(ws + WS_TOKP); int* list = (int*)(ws + WS_LIST);
        unsigned* cnt = F.ctl + CW_CNT; const float* x1 = args.out;
        for (int t = gw; t < T; t += NGW) {
            float xv[16]; float s = 0.f;
#pragma unroll
            for (int j = 0; j < 4; ++j) { const f32x4 a = ((const GAS f32x4*)(x1 + (size_t)t * D) + F.lane)[64 * j]; xv[4 * j] = a.x; xv[4 * j + 1] = a.y; xv[4 * j + 2] = a.z; xv[4 * j + 3] = a.w; s += (a.x * a.x + a.y * a.y) + (a.z * a.z + a.w * a.w); }
            const float rs = rsqrtf(wave_sum(s) * (1.f / D) + EPS);
            GAS unsigned long long* o8 = (GAS unsigned long long*)(xb + (size_t)t * D) + F.lane;
#pragma unroll
            for (int j = 0; j < 4; ++j) { o8[64 * j] = (unsigned long long)pk2(xv[4 * j] * rs, xv[4 * j + 1] * rs) | ((unsigned long long)pk2(xv[4 * j + 2] * rs, xv[4 * j + 3] * rs) << 32); }
#pragma unroll
            for (int j = 0; j < 4; ++j) { const f32x4 gg = ((const GAS f32x4*)g2 + F.lane)[64 * j]; xv[4 * j] *= rs * gg.x; xv[4 * j + 1] *= rs * gg.y; xv[4 * j + 2] *= rs * gg.z; xv[4 * j + 3] *= rs * gg.w; }
            float gl[4] = {};
#pragma unroll
            for (int j = 0; j < 4; ++j)
#pragma unroll
                for (int q = 0; q < 4; ++q) { const int k = 4 * F.lane + 256 * j + q; const f32x4 w = *(const GAS f32x4*)(rgw + (size_t)k * 4); const float a = xv[4 * j + q]; gl[0] += a * w.x; gl[1] += a * w.y; gl[2] += a * w.z; gl[3] += a * w.w; }
#pragma unroll
            for (int c = 0; c < 4; ++c) gl[c] = wave_sum(gl[c]) + rgb[c];
            int gi = 0; float gm = gl[0];
#pragma unroll
            for (int c = 1; c < 4; ++c) if (gl[c] > gm) { gm = gl[c]; gi = c; }
            float gs = 0.f;
#pragma unroll
            for (int c = 0; c < 4; ++c) gs += expf(gl[c] - gm);
            const float gwt = 1.f / gs;
            float el[8] = {};
#pragma unroll
            for (int j = 0; j < 4; ++j)
#pragma unroll
                for (int q = 0; q < 4; ++q) { const int k = 4 * F.lane + 256 * j + q; const f32x4 w0 = *(const GAS f32x4*)(rew + (size_t)k * 32 + gi * 8), w1 = *(const GAS f32x4*)(rew + (size_t)k * 32 + gi * 8 + 4); const float a = xv[4 * j + q];
                    el[0] += a * w0.x; el[1] += a * w0.y; el[2] += a * w0.z; el[3] += a * w0.w; el[4] += a * w1.x; el[5] += a * w1.y; el[6] += a * w1.z; el[7] += a * w1.w; }
#pragma unroll
            for (int c = 0; c < 8; ++c) el[c] = wave_sum(el[c]) + reb[gi * 8 + c];
            int i0 = 0; float m0 = el[0];
#pragma unroll
            for (int c = 1; c < 8; ++c) if (el[c] > m0) { m0 = el[c]; i0 = c; }
            int i1 = 0; float m1 = -INFINITY;
#pragma unroll
            for (int c = 0; c < 8; ++c) if (c != i0 && el[c] > m1) { m1 = el[c]; i1 = c; }
            const float p1 = expf(m1 - m0);
            const float w0 = gwt / (1.f + p1), w1 = gwt * p1 / (1.f + p1);
            if (F.lane == 0) {
                rs2o[t] = rs;
                const int e0 = gi * 8 + i0, e1 = gi * 8 + i1;
                const int p0 = (int)atomicAdd(&cnt[e0], 1u), p1i = (int)atomicAdd(&cnt[e1], 1u);
                list[e0 * T + p0] = t; list[e1 * T + p1i] = t;
                tok_e[2 * t] = e0; tok_e[2 * t + 1] = e1; tok_w[2 * t] = w0; tok_w[2 * t + 1] = w1; tok_p[2 * t] = p0; tok_p[2 * t + 1] = p1i;
            }
        }
        __syncthreads();
        LAS float* scr = (LAS float*)(F.lds + F.wave * 16384);
        const float* Wg = args.in[24]; const float* Wu = args.in[25]; const float* Wd = args.in[26];
        bf16* wgu = (bf16*)(ws + WS_WGU); bf16* wd = (bf16*)(ws + WS_WD);
        for (int it = gw; it < NE * 768; it += NGW) {
            const int e = it / 768, r = it % 768;
            if (r < 512) { const int up = r >> 8, rr = r & 255, kb = rr >> 4, nb = rr & 15, n0 = nb * 32;
                const int drow = (n0 >> 7) * 256 + up * 128 + (n0 & 127);
                transpose_item((up ? Wu : Wg) + (size_t)e * D * DE, DE, kb * 64, n0, wgu + (size_t)e * 1024 * 1024, D, drow, g2, scr, F.lane); }
            else { const int rr = r - 512, kb = rr >> 5, nb = rr & 31; transpose_item(Wd + (size_t)e * DE * D, D, kb * 64, nb * 32, wd + (size_t)e * 1024 * 512, DE, nb * 32, nullptr, scr, F.lane); }
        }
    }
    SEAM(7);
    if (IN(8) || IN(9)) {
        LAS int* toff = (LAS int*)(F.lds + LDS_AUX); LAS int* soff = toff + 40; LAS int* tokl = toff + 128;
        if (F.tid == 0) { int a = 0, b = 0; for (int e = 0; e < NE; ++e) { const int c = (int)xb_ld(F.ctl + CW_CNT + e); toff[e] = a; soff[e] = b; a += (c + 255) >> 8; b += c; } toff[NE] = a; soff[NE] = b; }
        __syncthreads();
        MoeSched S; S.G = F.G; S.c = F.vcu; S.toff = toff; S.soff = soff; S.tokl = tokl; S.nunits = toff[NE] * 4;
        S.A = xb; S.Bt = (const bf16*)(ws + WS_WGU); S.K = D; S.lda = D; S.ldb = D; S.bstride = (size_t)1024 * 1024; S.gather = true;
        if (IN(8)) {
            const int* list = (const int*)(ws + WS_LIST);
            for (int i = 0; i < MOE_MAXU; ++i) { pg8::Unit u; if (!S.next(i, u)) break; if (F.tid < 256) { const int r = min(F.tid, u.rows - 1); tokl[i * 256 + F.tid] = list[u.e * T + u.pm * 256 + r]; } }
            __syncthreads();
            EpiGateUp E{(bf16*)(ws + WS_H)};
            pg8::gemm_phase<EpiGateUp, MoeSched>(F.lds, S, E);
        }
        SEAM(8);
        if (IN(9)) {
            S.A = (const bf16*)(ws + WS_H); S.Bt = (const bf16*)(ws + WS_WD); S.K = DE; S.lda = DE; S.ldb = DE; S.bstride = (size_t)1024 * 512; S.gather = false;
            EpiDown E{(bf16*)(ws + WS_Y)};
            pg8::gemm_phase<EpiDown, MoeSched>(F.lds, S, E);
        }
    }
    SEAM(9);
    if (IN(10)) {
        LAS int* soff = (LAS int*)(F.lds + LDS_AUX) + 40;
        if (!IN(9)) { if (F.tid == 0) { int b = 0; for (int e = 0; e < NE; ++e) { soff[e] = b; b += (int)xb_ld(F.ctl + CW_CNT + e); } } __syncthreads(); }
        const float* gf = args.in[27]; const int* tok_e = (const int*)(ws + WS_TOKE); const float* tok_w = (const float*)(ws + WS_TOKW); const int* tok_p = (const int*)(ws + WS_TOKP);
        const bf16* Y = (const bf16*)(ws + WS_Y); float* out = args.out;
        for (int t = gw; t < T; t += NGW) {
            const int s0 = soff[tok_e[2 * t]] + tok_p[2 * t], s1 = soff[tok_e[2 * t + 1]] + tok_p[2 * t + 1]; const float w0 = tok_w[2 * t], w1 = tok_w[2 * t + 1];
            f32x4 v[4]; float s = 0.f;
#pragma unroll
            for (int j = 0; j < 4; ++j) {
                const f32x4 a = ((const GAS f32x4*)(out + (size_t)t * D) + F.lane)[64 * j];
                const v2u y0 = ((const GAS v2u*)(Y + (size_t)s0 * D) + F.lane)[64 * j], y1 = ((const GAS v2u*)(Y + (size_t)s1 * D) + F.lane)[64 * j];
                v[j].x = a.x + (w0 * bf2f(y0.x & 0xffffu) + w1 * bf2f(y1.x & 0xffffu)); v[j].y = a.y + (w0 * bf2f(y0.x >> 16) + w1 * bf2f(y1.x >> 16));
                v[j].z = a.z + (w0 * bf2f(y0.y & 0xffffu) + w1 * bf2f(y1.y & 0xffffu)); v[j].w = a.w + (w0 * bf2f(y0.y >> 16) + w1 * bf2f(y1.y >> 16));
                s += (v[j].x * v[j].x + v[j].y * v[j].y) + (v[j].z * v[j].z + v[j].w * v[j].w); }
            const float rs = rsqrtf(wave_sum(s) * (1.f / D) + EPS);
#pragma unroll
            for (int j = 0; j < 4; ++j) { const f32x4 gg = ((const GAS f32x4*)gf + F.lane)[64 * j]; ((GAS f32x4*)(out + (size_t)t * D) + F.lane)[64 * j] = (f32x4){v[j].x * rs * gg.x, v[j].y * rs * gg.y, v[j].z * rs * gg.z, v[j].w * rs * gg.w}; }
        }
    }
#undef IN
#undef SEAM
}

extern "C" void kernel_launch(void* const* d_in, const int* in_sizes, int n_in, void* d_out, int out_size, void* d_ws, size_t ws_size, hipStream_t stream) {
    static int grid = 0;
    if (grid == 0) {
        int dev = 0, cus = 0, per_cu = 0;
        if (hipGetDevice(&dev) != hipSuccess || hipDeviceGetAttribute(&cus, hipDeviceAttributeMultiprocessorCount, dev) != hipSuccess) { grid = -1; return; }
        if (hipFuncSetAttribute((const void*)mk_fwd, hipFuncAttributeMaxDynamicSharedMemorySize, LDS_BYTES) != hipSuccess) { grid = -1; return; }
        if (hipOccupancyMaxActiveBlocksPerMultiprocessor(&per_cu, (const void*)mk_fwd, NTHR, LDS_BYTES) != hipSuccess || per_cu < 1) per_cu = 1;
        (void)hipGetLastError();
        grid = cus;
    }
    if (grid < 0) return;
    unsigned char* ws = (unsigned char*)d_ws;
    (void)hipMemsetAsync(ws + WS_CTL, 0, CTL_ZERO_BYTES, stream);
    Args a{};
    for (int i = 0; i < 28; ++i) a.in[i] = (const float*)d_in[i];
    a.out = (float*)d_out; a.ws = ws;
    auto launch = [&](int lo, int hi) { a.ph_lo = lo; a.ph_hi = hi; hipLaunchKernelGGL(mk_fwd, dim3(grid), dim3(NTHR), LDS_BYTES, stream, a); };
#ifndef MK_SPLIT
#define MK_SPLIT 0
#endif
    if (MK_SPLIT) { for (int p = 0; p < 11; ++p) launch(p, p + 1); }
    else launch(0, 11);
}
```

```cpp
#include <hip/hip_runtime.h>
#include <math.h>
#include <stdint.h>

constexpr int T = 16384, L = 8192, D = 1024, NP = 2568;
constexpr int NH = 4, HD = 128;
constexpr int SG = 32, SC = 16, SN = 64;
constexpr int NE = 32, DE = 512;
constexpr float EPS = 1e-6f;
constexpr int LC = 32, NCH = T / LC;
constexpr int AGK = 640;

#define GAS __attribute__((address_space(1)))
#define LAS __attribute__((address_space(3)))
typedef unsigned short bf16;
typedef unsigned v4u __attribute__((ext_vector_type(4)));
typedef unsigned v2u __attribute__((ext_vector_type(2)));
typedef float f32x4 __attribute__((ext_vector_type(4)));
typedef float f32x2 __attribute__((ext_vector_type(2)));
typedef short bf16x8 __attribute__((ext_vector_type(8)));

__device__ __forceinline__ unsigned f2bf(float f) { unsigned u = __builtin_bit_cast(unsigned, f); return (u + 0x7fffu + ((u >> 16) & 1u)) >> 16; }
__device__ __forceinline__ unsigned pk2(float lo, float hi) { return f2bf(lo) | (f2bf(hi) << 16); }
__device__ __forceinline__ float bf2f(unsigned b) { return __builtin_bit_cast(float, b << 16); }
__device__ __forceinline__ float wave_sum(float v) {
#pragma unroll
    for (int o = 1; o < 64; o <<= 1) v += __shfl_xor(v, o);
    return v;
}
__device__ __forceinline__ float sigmoidf_(float x) { return 1.f / (1.f + __expf(-x)); }
__device__ __forceinline__ float siluf_(float x) { return x / (1.f + __expf(-x)); }
__device__ __forceinline__ float log_sigmoidf_(float x) { return fminf(x, 0.f) - log1pf(expf(-fabsf(x))); }
__device__ __forceinline__ float gelu_tanh(float x) { const float u = 0.7978845608028654f * (x + 0.044715f * x * x * x); return x / (1.f + __expf(-2.f * u)); }

constexpr size_t MiB = 1u << 20;
constexpr size_t WS_CTL = 0, CTL_ZERO_BYTES = 64 * 1024;
constexpr size_t WS_WIN = 1 * MiB;
constexpr size_t WS_WOUT = 6 * MiB;
constexpr size_t WS_TQ = 8 * MiB;
constexpr size_t WS_PG = 28 * MiB;
constexpr size_t WS_SMALL = 33 * MiB;
constexpr size_t WS_GATES = WS_SMALL;
constexpr size_t WS_RS2 = WS_SMALL + 512 * 1024;
constexpr size_t WS_TOKE = WS_RS2 + 64 * 1024;
constexpr size_t WS_TOKW = WS_TOKE + 128 * 1024;
constexpr size_t WS_TOKP = WS_TOKW + 128 * 1024;
constexpr size_t WS_LIST = WS_SMALL + 1 * MiB;
constexpr size_t WS_S5PAR = WS_SMALL + 3 * MiB;
constexpr size_t WS_MSC = WS_SMALL + 3 * MiB + 64 * 1024;
constexpr size_t WS_DN = WS_SMALL + 4 * MiB;
constexpr size_t WS_WRH = WS_SMALL + 5 * MiB;
constexpr size_t WS_WRL = WS_SMALL + 5 * MiB + 128 * 1024;
constexpr size_t WS_XB = 40 * MiB;
constexpr size_t WS_QKVO = 72 * MiB;
constexpr size_t WS_DC = 136 * MiB;
constexpr size_t WS_WGU = 72 * MiB;
constexpr size_t WS_WD = 136 * MiB;
constexpr size_t WS_AG = 168 * MiB;
constexpr size_t WS_EE = 188 * MiB;
constexpr size_t WS_Y5 = 196 * MiB;
constexpr size_t WS_H = 168 * MiB;
constexpr size_t WS_Y = 201 * MiB;
constexpr size_t WS_END = 266 * MiB;
constexpr int CW_CNT = 1024;
constexpr int CW_BAR = 4096;

namespace pg8 {
typedef unsigned u32x4 __attribute__((ext_vector_type(4)));
constexpr int BM = 256, BK = 64, HALF = 128, HTB = HALF * BK * 2, STAGE_BYTES = 8 * HTB;
__host__ __device__ __forceinline__ int lds_byte(int r, int c) { const int st = (r >> 4) * 2 + (c >> 5), rr = r & 15, cc = c & 31, ob = rr * 64 + cc * 2; return st * 1024 + (ob ^ (((ob >> 9) & 1) << 5)); }
__host__ __device__ __forceinline__ void stage_rc(int b, int& R, int& C) { const int st = b / 1024, sb = b % 1024, swz = sb ^ (((sb >> 9) & 1) << 5); R = (st >> 1) * 16 + swz / 64; C = (st & 1) * 32 + (swz % 64) / 2; }
__host__ __device__ __forceinline__ int perm32(int rho) { const int n = rho >> 4, i = rho & 15; return 8 * (i >> 2) + 4 * n + (i & 3); }
__device__ __forceinline__ unsigned cvt_pk_bf16(float lo, float hi) { unsigned r; asm volatile("v_cvt_pk_bf16_f32 %0, %1, %2" : "=v"(r) : "v"(lo), "v"(hi)); return r; }

struct Unit { int pm, pn, e, rows, slot0, lidx; };

template <class Epi, class Sched, bool ALIGN_EPI = true>
__device__ __forceinline__ void gemm_phase(LAS unsigned char* lds, const Sched& S, const Epi& E) {
    const int tid = threadIdx.x, wid = __builtin_amdgcn_readfirstlane(tid >> 6), lane = tid & 63, wr = wid >> 2, wc = wid & 3, fr = lane & 15, fq = lane >> 4;
    const int K = S.K, nt = K / BK;
    int Rr[2], Cc[2];
    unsigned voffA[2][2], voffB[2], voffN[2][2];
#pragma unroll
    for (int i = 0; i < 2; ++i) { int R, C; stage_rc(tid * 16 + i * 8192, R, C); Rr[i] = R; Cc[i] = C; const int Rb = Epi::PERM ? ((R & ~31) + perm32(R & 31)) : R;
        voffB[i] = (unsigned)(Rb * S.ldb + C) * 2u; }
    const size_t kstep = (size_t)(BK * 2);
    const size_t hstepB = (size_t)HALF * S.ldb * 2;
    const unsigned ldsw = (unsigned)wid * 1024u;
    const int aoff = lds_byte(wr * 64 + fr, fq * 8), boff = lds_byte(wc * 32 + fr, fq * 8);
#define PG8_SA(b, h) (((b) * 2 + (h)) * HTB)
#define PG8_SB(b, h) ((4 + (b) * 2 + (h)) * HTB)
#define PG8_STAGE(bufoff, gbase, voff) do { _Pragma("unroll") for (int _i = 0; _i < 2; ++_i) \
        __builtin_amdgcn_global_load_lds((const unsigned*)((const char*)(gbase) + (voff)[_i]), (LAS unsigned*)(lds + (bufoff) + ldsw + _i * 8192), 16, 0, 0); } while (0)
#define PG8_LDA(dst, b, h) do { _Pragma("unroll") for (int m = 0; m < 4; ++m) _Pragma("unroll") for (int k = 0; k < 2; ++k) dst[m][k] = *(const LAS bf16x8*)(lds + PG8_SA(b, h) + aoff + m * 2048 + k * 1024); } while (0)
#define PG8_LDB(dst, b, h) do { _Pragma("unroll") for (int n = 0; n < 2; ++n) _Pragma("unroll") for (int k = 0; k < 2; ++k) dst[n][k] = *(const LAS bf16x8*)(lds + PG8_SB(b, h) + boff + n * 2048 + k * 1024); } while (0)
#define PG8_MMA(ai, bj, At, Bt) do { __builtin_amdgcn_s_setprio(1); _Pragma("unroll") for (int m = 0; m < 4; ++m) _Pragma("unroll") for (int n = 0; n < 2; ++n) _Pragma("unroll") for (int k = 0; k < 2; ++k) \
        acc[ai][bj][m][n] = __builtin_amdgcn_mfma_f32_16x16x32_bf16(Bt[n][k], At[m][k], acc[ai][bj][m][n], 0, 0, 0); __builtin_amdgcn_s_setprio(0); } while (0)
#define PG8_WAIT_V(n) asm volatile("s_waitcnt vmcnt(" #n ")" ::: "memory")
#define PG8_WAIT_L(n) asm volatile("s_waitcnt lgkmcnt(" #n ")" ::: "memory")
#define PG8_BAR __builtin_amdgcn_s_barrier()
#define PG8_SCHED __builtin_amdgcn_sched_barrier(0)
#define PG8_AOFF(dst, u) do { _Pragma("unroll") for (int _h = 0; _h < 2; ++_h) _Pragma("unroll") for (int _i = 0; _i < 2; ++_i) \
        dst[_h][_i] = (unsigned)(((size_t)S.a_row(u, _h * HALF + Rr[_i]) * S.lda + Cc[_i]) * 2u); } while (0)
    Unit cur, nxt; int ui = 0;
    if (!S.next(0, cur)) return;
    f32x4 acc[2][2][4][2];
#pragma unroll
    for (int a = 0; a < 2; ++a)
#pragma unroll
        for (int b = 0; b < 2; ++b)
#pragma unroll
            for (int m = 0; m < 4; ++m)
#pragma unroll
                for (int n = 0; n < 2; ++n) acc[a][b][m][n] = (f32x4){0.f, 0.f, 0.f, 0.f};
    bf16x8 At[4][2], B0[2][2], B1[2][2];
    const char* cA = S.a_ptr(cur); const char* cB = S.b_ptr(cur);
    PG8_AOFF(voffA, cur);
    PG8_STAGE(PG8_SB(0, 0), cB, voffB); PG8_STAGE(PG8_SB(0, 1), cB + hstepB, voffB); PG8_STAGE(PG8_SA(0, 0), cA, voffA[0]); PG8_STAGE(PG8_SA(0, 1), cA, voffA[1]);
    if (wr == 1) PG8_BAR;
    PG8_WAIT_V(2); PG8_BAR;
    PG8_STAGE(PG8_SB(1, 0), cB + kstep, voffB); PG8_STAGE(PG8_SA(1, 0), cA + kstep, voffA[0]); PG8_STAGE(PG8_SB(1, 1), cB + hstepB + kstep, voffB);
    PG8_WAIT_V(6); PG8_BAR;
    for (;;) {
        const bool has_next = S.next(ui + 1, nxt);
        const char* nA = has_next ? S.a_ptr(nxt) : cA; const char* nB = has_next ? S.b_ptr(nxt) : cB;
        if (has_next) { PG8_AOFF(voffN, nxt); } else {
#pragma unroll
            for (int h = 0; h < 2; ++h)
#pragma unroll
                for (int i = 0; i < 2; ++i) voffN[h][i] = voffA[h][i]; }
        for (int t = 0; t < nt; t += 2) {
            const bool last = (t == nt - 2);
            const char* a1 = cA + (size_t)(t + 1) * kstep;
            const char* a2 = last ? nA : cA + (size_t)(t + 2) * kstep; const char* b2 = last ? nB : cB + (size_t)(t + 2) * kstep;
            const char* a3 = a2 + kstep; const char* b3 = b2 + kstep;
            unsigned vo2[2][2];
#pragma unroll
            for (int h = 0; h < 2; ++h)
#pragma unroll
                for (int i = 0; i < 2; ++i) vo2[h][i] = last ? voffN[h][i] : voffA[h][i];
            PG8_LDB(B0, 0, 0); PG8_LDB(B1, 0, 1); PG8_SCHED; PG8_LDA(At, 0, 0); PG8_STAGE(PG8_SA(1, 1), a1, voffA[1]);
            PG8_WAIT_V(8); PG8_WAIT_L(0); PG8_BAR; PG8_MMA(0, 0, At, B0); PG8_MMA(0, 1, At, B1); PG8_BAR; PG8_SCHED;
            PG8_LDA(At, 0, 1); PG8_STAGE(PG8_SB(0, 0), b2, voffB); PG8_STAGE(PG8_SB(0, 1), b2 + hstepB, voffB); PG8_STAGE(PG8_SA(0, 0), a2, vo2[0]);
            PG8_WAIT_V(8); PG8_WAIT_L(0); PG8_BAR; PG8_MMA(1, 0, At, B0); PG8_MMA(1, 1, At, B1); PG8_BAR; PG8_SCHED;
            PG8_LDB(B0, 1, 0); PG8_LDB(B1, 1, 1); PG8_SCHED; PG8_LDA(At, 1, 0); PG8_STAGE(PG8_SA(0, 1), a2, vo2[1]);
            PG8_WAIT_V(8); PG8_WAIT_L(0); PG8_BAR; PG8_MMA(0, 0, At, B0); PG8_MMA(0, 1, At, B1); PG8_BAR; PG8_SCHED;
            PG8_LDA(At, 1, 1); PG8_STAGE(PG8_SB(1, 0), b3, voffB); PG8_STAGE(PG8_SB(1, 1), b3 + hstepB, voffB); PG8_STAGE(PG8_SA(1, 0), a3, vo2[0]);
            PG8_WAIT_V(8); PG8_WAIT_L(0); PG8_BAR; PG8_MMA(1, 0, At, B0); PG8_MMA(1, 1, At, B1); PG8_BAR; PG8_SCHED;
        }
        if constexpr (ALIGN_EPI) { if (wr == 0) PG8_BAR; }
        E(acc, cur, wr, wc, fr, fq);
        if (!has_next) break;
#pragma unroll
        for (int a = 0; a < 2; ++a)
#pragma unroll
            for (int b = 0; b < 2; ++b)
#pragma unroll
                for (int m = 0; m < 4; ++m)
#pragma unroll
                    for (int n = 0; n < 2; ++n) acc[a][b][m][n] = (f32x4){0.f, 0.f, 0.f, 0.f};
        cur = nxt; cA = nA; cB = nB; ++ui;
#pragma unroll
        for (int h = 0; h < 2; ++h)
#pragma unroll
            for (int i = 0; i < 2; ++i) voffA[h][i] = voffN[h][i];
        if constexpr (ALIGN_EPI) { if (wr == 1) PG8_BAR; }
    }
    PG8_WAIT_V(0);
    if constexpr (!ALIGN_EPI) { if (wr == 0) PG8_BAR; }
    PG8_BAR;
#undef PG8_SA
#undef PG8_SB
#undef PG8_STAGE
#undef PG8_LDA
#undef PG8_LDB
#undef PG8_MMA
#undef PG8_WAIT_V
#undef PG8_WAIT_L
#undef PG8_BAR
#undef PG8_SCHED
#undef PG8_AOFF
}
}

#define XB_TMO      128
#define XB_XCNT(j)  (256  + 64 * (j))
#define XB_XSUB(j)  (1280 + 64 * (j))
#define XB_XGEN(j)  (2304 + 64 * (j))
#define XB_TOP      3328
#define XB_TOPGEN   3392
#define XCD_BAR_WORDS 3456
#define XB_SPIN_CAP (1u << 20)
__device__ __forceinline__ unsigned xb_ld(unsigned* p)              { return __hip_atomic_load(p, __ATOMIC_RELAXED, __HIP_MEMORY_SCOPE_AGENT); }
__device__ __forceinline__ unsigned xb_add(unsigned* p, unsigned v) { return __hip_atomic_fetch_add(p, v, __ATOMIC_RELAXED, __HIP_MEMORY_SCOPE_AGENT); }
__device__ __forceinline__ unsigned xb_xcc_id() { return (unsigned)__builtin_amdgcn_s_getreg((3 << 11) | 20) & 0xFu; }
#define XB_SPIN(cond, bar) do { unsigned _sp = 0; while (cond) { __builtin_amdgcn_s_sleep(1); \
    if ((++_sp & 255u) == 0u) { if (xb_ld(&(bar)[XB_TMO])) break; if (_sp > XB_SPIN_CAP) { atomicAdd(&(bar)[XB_TMO], 1u); break; } } } } while (0)
struct XcdBarrier { unsigned* bar; unsigned x; volatile LAS unsigned* st; };
__device__ __forceinline__ XcdBarrier xcd_barrier_post(unsigned* bar, volatile LAS unsigned* st) {
    XcdBarrier b; b.bar = bar; b.x = xb_xcc_id(); b.st = st;
    if (threadIdx.x == 0) (void)xb_add(&bar[XB_XCNT(b.x)], 1u);
    return b;
}
__device__ __forceinline__ void xcd_barrier_complete(unsigned* bar, unsigned x, unsigned& nloc, unsigned& nx) {
    const unsigned G = gridDim.x * gridDim.y * gridDim.z;
    unsigned sum, cnt, mine, sp = 0u;
    for (;;) {
        sum = 0u; cnt = 0u; mine = 0u;
#pragma unroll
        for (unsigned j = 0; j < 16; ++j) { const unsigned c = xb_ld(&bar[XB_XCNT(j)]); sum += c; cnt += (c > 0u) ? 1u : 0u; mine = (j == x) ? c : mine; }
        if (sum == G) break;
        __builtin_amdgcn_s_sleep(1);
        if ((++sp & 255u) == 0u) { if (xb_ld(&bar[XB_TMO])) break; if (sp > XB_SPIN_CAP) { atomicAdd(&bar[XB_TMO], 1u); break; } }
    }
    nloc = mine > 0u ? mine : 1u; nx = cnt > 0u ? cnt : 1u;
}
__device__ __forceinline__ void xcd_barrier(const XcdBarrier& b) {
    asm volatile("s_waitcnt vmcnt(0)" ::: "memory");
    __syncthreads();
    if (threadIdx.x == 0) {
        unsigned* bar = b.bar;
        __builtin_amdgcn_s_waitcnt(0);
        unsigned nloc = b.st[0], nx = b.st[1];
        if (nloc == 0u) { xcd_barrier_complete(bar, b.x, nloc, nx); b.st[0] = nloc; b.st[1] = nx; }
        const unsigned old = xb_add(&bar[XB_XSUB(b.x)], 1u);
        const unsigned gen = old / nloc;
        if (old + 1u == (gen + 1u) * nloc) {
            __builtin_amdgcn_fence(__ATOMIC_RELEASE, "agent");
            asm volatile("s_waitcnt vmcnt(0)" ::: "memory");
            const unsigned og = xb_add(&bar[XB_TOP], 1u);
            const unsigned tg = og / nx;
            if (og + 1u == (tg + 1u) * nx) xb_add(&bar[XB_TOPGEN], 1u);
            else XB_SPIN(xb_ld(&bar[XB_TOPGEN]) == tg, bar);
            __builtin_amdgcn_fence(__ATOMIC_ACQUIRE, "agent");
            xb_add(&bar[XB_XGEN(b.x)], 1u);
            asm volatile("s_waitcnt vmcnt(0)" ::: "memory");
        } else {
            XB_SPIN(xb_ld(&bar[XB_XGEN(b.x)]) == gen, bar);
            __builtin_amdgcn_fence(__ATOMIC_ACQUIRE, "agent");
            asm volatile("s_waitcnt vmcnt(0)" ::: "memory");
        }
    }
    __syncthreads();
}

constexpr int NWAVES = 8, NTHR = 512;
constexpr int RING_BYTES = 131072;
constexpr int LDS_AUX = RING_BYTES;
constexpr int LDS_AUX_BYTES = 12288;
constexpr int MISC_OFF = LDS_AUX + LDS_AUX_BYTES;
constexpr int LDS_BYTES = MISC_OFF + 256;

struct Args {
    const float* in[28]; float* out; unsigned char* ws; int ph_lo, ph_hi;
};
struct Frame {
    LAS unsigned char* lds; volatile LAS unsigned* MISC; unsigned* ctl;
    int tid, lane, wave, vcu, G;
    unsigned char* ws;
};

__device__ __forceinline__ void transpose_item(const float* W, int ldw, int k0, int scol0, bf16* WT, int ldt, int drow0, const float* ks, LAS float* scr, int lane) {
#pragma unroll 8
    for (int i = 0; i < 32; ++i) { const int kk = 2 * i + (lane >> 5); float v = W[(size_t)(k0 + kk) * ldw + scol0 + (lane & 31)]; if (ks) v *= ks[k0 + kk]; scr[kk * 33 + (lane & 31)] = v; }
    asm volatile("s_waitcnt lgkmcnt(0)" ::: "memory");
    const int c = lane & 7;
#pragma unroll
    for (int j = 0; j < 4; ++j) { const int n = (lane >> 3) + 8 * j; const LAS float* s = scr + (8 * c) * 33 + n;
        v4u o; o.x = pk2(s[0 * 33], s[1 * 33]); o.y = pk2(s[2 * 33], s[3 * 33]); o.z = pk2(s[4 * 33], s[5 * 33]); o.w = pk2(s[6 * 33], s[7 * 33]);
        *(v4u*)(WT + (size_t)(drow0 + n) * ldt + k0 + 8 * c) = o; }
    asm volatile("s_waitcnt lgkmcnt(0)" ::: "memory");
}

__device__ __forceinline__ void tconv64(const float* W, int ldw, int k0, int scol0, bf16* WT, int ldt, int drow0, const float* ks, LAS unsigned char* scr, int lane) {
    const int rsub = lane >> 4, c4 = lane & 15;
    f32x4 v[16];
    const float* src = W + (size_t)(k0 + 16 * rsub) * ldw + scol0 + 4 * c4;
#pragma unroll
    for (int i = 0; i < 16; ++i) v[i] = *(const f32x4*)(src + (size_t)i * ldw);
    if (ks) {
#pragma unroll
        for (int q = 0; q < 4; ++q) { const f32x4 s4 = *(const f32x4*)(ks + k0 + 16 * rsub + 4 * q);
            v[4 * q] = v[4 * q] * s4.x; v[4 * q + 1] = v[4 * q + 1] * s4.y; v[4 * q + 2] = v[4 * q + 2] * s4.z; v[4 * q + 3] = v[4 * q + 3] * s4.w; } }
    const int swz = c4 & 7;
#pragma unroll
    for (int j = 0; j < 4; ++j) { const int n = 4 * c4 + j;
        const v4u lo = (v4u){pk2(v[0][j], v[1][j]), pk2(v[2][j], v[3][j]), pk2(v[4][j], v[5][j]), pk2(v[6][j], v[7][j])};
        const v4u hi = (v4u){pk2(v[8][j], v[9][j]), pk2(v[10][j], v[11][j]), pk2(v[12][j], v[13][j]), pk2(v[14][j], v[15][j])};
        *(LAS v4u*)(scr + n * 128 + (((2 * rsub) ^ swz) * 16)) = lo;
        *(LAS v4u*)(scr + n * 128 + (((2 * rsub + 1) ^ swz) * 16)) = hi; }
    asm volatile("s_waitcnt lgkmcnt(0)" ::: "memory");
#pragma unroll
    for (int i = 0; i < 8; ++i) { const int n = 8 * i + (lane >> 3), ch = lane & 7;
        const v4u o = *(const LAS v4u*)(scr + n * 128 + ((ch ^ ((n >> 2) & 7)) * 16));
        *(v4u*)(WT + (size_t)(drow0 + n) * ldt + k0 + 8 * ch) = o; }
    asm volatile("s_waitcnt lgkmcnt(0)" ::: "memory");
}

struct DenseSched {
    static constexpr int NXCD = 8, WGM = 8;
    const bf16* A; const bf16* Bt; int K, lda, ldb, nM, nN, nwg, G, c, reps;
    __device__ void init(const bf16* A_, const bf16* Bt_, int M, int N, int K_, int lda_, int ldb_, int G_, int c_) { A = A_; Bt = Bt_; K = K_; lda = lda_; ldb = ldb_; nM = M / 256; nN = N / 256; nwg = nM * nN; G = G_; c = c_; reps = 1; }
    __device__ __forceinline__ bool next(int i, pg8::Unit& u) const {
        const long Lx = (long)i * G + c; if (Lx >= (long)nwg * reps) return false;
        int wgid = (int)(Lx % nwg); { const int q = nwg / NXCD, r = nwg % NXCD, xcd = wgid % NXCD, off = wgid / NXCD; wgid = (xcd < r ? xcd * (q + 1) : r * (q + 1) + (xcd - r) * q) + off; }
        const int nig = WGM * nN, gid = wgid / nig, fm = gid * WGM, gsz = (nM - fm) < WGM ? (nM - fm) : WGM;
        u.pm = fm + ((wgid % nig) % gsz); u.pn = (wgid % nig) / gsz; u.e = 0; u.rows = 256; u.slot0 = u.pm * 256; u.lidx = i; return true;
    }
    __device__ __forceinline__ const char* a_ptr(const pg8::Unit&) const { return (const char*)A; }
    __device__ __forceinline__ const char* b_ptr(const pg8::Unit& u) const { return (const char*)(Bt + (size_t)u.pn * 256 * ldb); }
    __device__ __forceinline__ int a_row(const pg8::Unit& u, int r) const { return u.pm * 256 + r; }
};

constexpr int MOE_MAXU = 8;
struct MoeSched {
    const bf16* A; const bf16* Bt; int K, lda, ldb, G, c; size_t bstride;
    const LAS int* toff; const LAS int* soff; const LAS int* tokl;
    int nunits, reps; bool gather;
    __device__ __forceinline__ bool next(int i, pg8::Unit& u) const {
        int Lx = i * G + c; if (Lx >= nunits * reps) return false; Lx %= nunits;
        const int mtg = Lx >> 2; u.pn = Lx & 3;
        int e = 0;
#pragma unroll 1
        for (int j = 0; j < NE; ++j) if (toff[j + 1] <= mtg) e = j + 1;
        u.e = e; const int mt = mtg - toff[e]; u.pm = mt; const int ce = soff[e + 1] - soff[e];
        u.rows = min(256, ce - mt * 256); u.slot0 = soff[e] + mt * 256; u.lidx = i; return true;
    }
    __device__ __forceinline__ const char* a_ptr(const pg8::Unit&) const { return (const char*)A; }
    __device__ __forceinline__ const char* b_ptr(const pg8::Unit& u) const { return (const char*)(Bt + (size_t)u.e * bstride + (size_t)u.pn * 256 * ldb); }
    __device__ __forceinline__ int a_row(const pg8::Unit& u, int r) const { return gather ? tokl[u.lidx * 256 + r] : (u.slot0 + r); }
};

struct EpiInProj {
    static constexpr bool PERM = true;
    bf16* qkvo; bf16* ag;
    __device__ __forceinline__ void operator()(const f32x4 (&acc)[2][2][4][2], const pg8::Unit& u, int wr, int wc, int fr, int fq) const {
        const int row0 = u.pm * 256 + wr * 64 + fr; const int colt = u.pn * 256 + wc * 32 + 8 * fq;
#pragma unroll
        for (int ai = 0; ai < 2; ++ai)
#pragma unroll
            for (int m = 0; m < 4; ++m) { const int row = row0 + ai * 128 + m * 16;
#pragma unroll
                for (int bj = 0; bj < 2; ++bj) { const f32x4 v0 = acc[ai][bj][m][0], v1 = acc[ai][bj][m][1];
                    v4u w; w.x = pg8::cvt_pk_bf16(v0[0], v0[1]); w.y = pg8::cvt_pk_bf16(v0[2], v0[3]); w.z = pg8::cvt_pk_bf16(v1[0], v1[1]); w.w = pg8::cvt_pk_bf16(v1[2], v1[3]);
                    const int col = colt + bj * 128;
                    if (u.pn < 8) { *(v4u*)(qkvo + (size_t)(col >> 9) * T * 512 + (size_t)row * 512 + (col & 511)) = w; }
                    else { const int cu = col - 2048, g = cu >> 4, h0 = cu & 15; *(v4u*)(ag + ((size_t)g * NCH + (row >> 5)) * AGK + (row & 31) * 16 + h0) = w; } } }
    }
};
struct EpiResF32 {
    static constexpr bool PERM = false;
    const float* base; float* out;
    __device__ __forceinline__ void operator()(const f32x4 (&acc)[2][2][4][2], const pg8::Unit& u, int wr, int wc, int fr, int fq) const {
        const int row0 = u.pm * 256 + wr * 64 + fr, col0 = u.pn * 256 + wc * 32 + 4 * fq;
#pragma unroll
        for (int ai = 0; ai < 2; ++ai)
#pragma unroll
            for (int m = 0; m < 4; ++m) { const size_t off = (size_t)(row0 + ai * 128 + m * 16) * D + col0;
#pragma unroll
                for (int bj = 0; bj < 2; ++bj)
#pragma unroll
                    for (int n = 0; n < 2; ++n) { const f32x4 bs = *(const f32x4*)(base + off + bj * 128 + n * 16); *(f32x4*)(out + off + bj * 128 + n * 16) = bs + acc[ai][bj][m][n]; }
                asm volatile("" ::: "memory"); }
    }
};
struct EpiGateUp {
    static constexpr bool PERM = true;
    bf16* H; const LAS int* tokl; const float* rs2;
    __device__ __forceinline__ void operator()(const f32x4 (&acc)[2][2][4][2], const pg8::Unit& u, int wr, int wc, int fr, int fq) const {
        const int r0 = wr * 64 + fr; const int col = u.pn * 128 + wc * 32 + 8 * fq;
#pragma unroll
        for (int ai = 0; ai < 2; ++ai)
#pragma unroll
            for (int m = 0; m < 4; ++m) { const int r = r0 + ai * 128 + m * 16;
                const float rs = rs2[tokl[u.lidx * 256 + r]];
                float o[8];
#pragma unroll
                for (int n = 0; n < 2; ++n)
#pragma unroll
                    for (int j = 0; j < 4; ++j) o[4 * n + j] = siluf_(acc[ai][0][m][n][j] * rs) * (acc[ai][1][m][n][j] * rs);
                v4u w; w.x = pg8::cvt_pk_bf16(o[0], o[1]); w.y = pg8::cvt_pk_bf16(o[2], o[3]); w.z = pg8::cvt_pk_bf16(o[4], o[5]); w.w = pg8::cvt_pk_bf16(o[6], o[7]);
                if (r < u.rows) *(v4u*)(H + (size_t)(u.slot0 + r) * DE + col) = w; }
    }
};
struct EpiDown {
    static constexpr bool PERM = true;
    bf16* Y;
    __device__ __forceinline__ void operator()(const f32x4 (&acc)[2][2][4][2], const pg8::Unit& u, int wr, int wc, int fr, int fq) const {
        const int r0 = wr * 64 + fr; const int col = u.pn * 256 + wc * 32 + 8 * fq;
#pragma unroll
        for (int ai = 0; ai < 2; ++ai)
#pragma unroll
            for (int m = 0; m < 4; ++m) { const int r = r0 + ai * 128 + m * 16;
#pragma unroll
                for (int bj = 0; bj < 2; ++bj) { const f32x4 v0 = acc[ai][bj][m][0], v1 = acc[ai][bj][m][1];
                    v4u w; w.x = pg8::cvt_pk_bf16(v0[0], v0[1]); w.y = pg8::cvt_pk_bf16(v0[2], v0[3]); w.z = pg8::cvt_pk_bf16(v1[0], v1[1]); w.w = pg8::cvt_pk_bf16(v1[2], v1[3]);
                    if (r < u.rows) *(v4u*)(Y + (size_t)(u.slot0 + r) * D + col + bj * 128) = w; } }
    }
};


typedef short s16x4 __attribute__((ext_vector_type(4)));
typedef short v4i16_t __attribute__((ext_vector_type(4)));
typedef float f32x16 __attribute__((ext_vector_type(16)));
__device__ __forceinline__ unsigned off_b(unsigned row, unsigned ch) { return 256u * row + 16u * (ch ^ (((row & 3) << 2) | ((row >> 2) & 3))); }
__device__ __forceinline__ s16x4 vtr(const LAS unsigned char* p) { return __builtin_bit_cast(s16x4, __builtin_amdgcn_ds_read_tr16_b64_v4i16((LAS v4i16_t*)p)); }
__device__ __forceinline__ unsigned tr_addr(unsigned row_base, unsigned c, unsigned lane) { const unsigned q = (lane & 15) >> 2, p = lane & 3; return off_b(row_base + q, 2 * c + (p >> 1)) + 8 * (p & 1); }
__device__ __forceinline__ bf16x8 cat4(s16x4 lo, s16x4 hi) { bf16x8 r; r[0] = lo[0]; r[1] = lo[1]; r[2] = lo[2]; r[3] = lo[3]; r[4] = hi[0]; r[5] = hi[1]; r[6] = hi[2]; r[7] = hi[3]; return r; }
__device__ __forceinline__ float wave_max(float v) {
#pragma unroll
    for (int o = 1; o < 64; o <<= 1) v = fmaxf(v, __shfl_xor(v, o));
    return v;
}
__device__ __forceinline__ void chunk_gates(const float* gates, int t0, int h, int lane, float& bcs, float& g) {
    const float li = gates[(size_t)(t0 + lane) * 8 + h], lf = gates[(size_t)(t0 + lane) * 8 + 4 + h];
    bcs = lf;
#pragma unroll
    for (int o = 1; o < 64; o <<= 1) { const float tv = __shfl_up(bcs, o); if (lane >= o) bcs += tv; }
    g = li - bcs;
}
__device__ __forceinline__ void conv4x8(const bf16* src, int tl0, const float* cw, const float* cb, float scale, v4u (&outp)[4]) {
    v4u raw[7];
#pragma unroll
    for (int i = 0; i < 7; ++i) { raw[i] = (v4u){0u, 0u, 0u, 0u}; if (tl0 - 3 + i >= 0) raw[i] = *(const v4u*)(src + (ptrdiff_t)(i - 3) * 512); }
    float w[4][8], bb[8];
#pragma unroll
    for (int j = 0; j < 4; ++j) { const f32x4 a = *(const f32x4*)(cw + j * 1024), b = *(const f32x4*)(cw + j * 1024 + 4); w[j][0] = a.x; w[j][1] = a.y; w[j][2] = a.z; w[j][3] = a.w; w[j][4] = b.x; w[j][5] = b.y; w[j][6] = b.z; w[j][7] = b.w; }
    { const f32x4 a = *(const f32x4*)cb, b = *(const f32x4*)(cb + 4); bb[0] = a.x; bb[1] = a.y; bb[2] = a.z; bb[3] = a.w; bb[4] = b.x; bb[5] = b.y; bb[6] = b.z; bb[7] = b.w; }
#pragma unroll
    for (int r = 0; r < 4; ++r) {
        float o[8];
#pragma unroll
        for (int e = 0; e < 8; ++e) { float a = bb[e];
#pragma unroll
            for (int j = 0; j < 4; ++j) { const unsigned d = raw[r + j][e >> 1]; a += w[j][e] * bf2f((e & 1) ? (d >> 16) : (d & 0xffffu)); }
            o[e] = siluf_(a) * scale; }
        outp[r] = (v4u){pk2(o[0], o[1]), pk2(o[2], o[3]), pk2(o[4], o[5]), pk2(o[6], o[7])};
    }
}

__device__ __forceinline__ void mlstm_a_pair(const Frame& F, int pair, const bf16* qkvo, const float* gates, const float* conv_w, const float* conv_b, bf16* dC, float* dn, float* msc) {
    const int hb = F.wave >> 2, w4 = F.wave & 3, tid4 = F.tid & 255, lane = F.lane, g4 = lane >> 4;
    const int unit = 2 * pair + hb, bh = unit >> 7, c = unit & 127, b = bh >> 2, h = bh & 3, t0 = b * L + c * 64;
    LAS unsigned char* Kimg = F.lds + hb * 65536; LAS unsigned char* Vimg = Kimg + 16384;
    float bcs, g; chunk_gates(gates, t0, h, lane, bcs, g);
    const float gmax = wave_max(g), wgt = __expf(g - gmax), bl = __shfl(bcs, 63);
    if (w4 == 0 && lane == 0) { msc[unit * 4 + 0] = bl + gmax; msc[unit * 4 + 1] = bl; }
    const int d8 = tid4 & 15, rg = tid4 >> 4;
    { v4u kc[4]; conv4x8(qkvo + (size_t)1 * T * 512 + (size_t)(t0 + 4 * rg) * 512 + h * 128 + 8 * d8, c * 64 + 4 * rg, conv_w + 512 + h * 128 + 8 * d8, conv_b + 512 + h * 128 + 8 * d8, 0.08838834764831845f, kc);
#pragma unroll
      for (int r = 0; r < 4; ++r) { const float ws = __shfl(wgt, 4 * rg + r);
          v4u o;
#pragma unroll
          for (int q = 0; q < 4; ++q) o[q] = pk2(bf2f(kc[r][q] & 0xffffu) * ws, bf2f(kc[r][q] >> 16) * ws);
          *(LAS v4u*)(Kimg + off_b(4 * rg + r, d8)) = o; }
#pragma unroll
      for (int r = 0; r < 4; ++r) *(LAS v4u*)(Vimg + off_b(4 * rg + r, d8)) = *(const v4u*)(qkvo + (size_t)2 * T * 512 + (size_t)(t0 + 4 * rg + r) * 512 + h * 128 + 8 * d8); }
    __syncthreads();
    f32x4 acc[2][8], accn[2];
#pragma unroll
    for (int a = 0; a < 2; ++a) { accn[a] = (f32x4){0.f, 0.f, 0.f, 0.f};
#pragma unroll
        for (int n = 0; n < 8; ++n) acc[a][n] = (f32x4){0.f, 0.f, 0.f, 0.f}; }
    bf16x8 ones; { const short o = ((lane & 15) == 0) ? (short)0x3F80 : (short)0;
#pragma unroll
        for (int j = 0; j < 8; ++j) ones[j] = o; }
#pragma unroll
    for (int ks = 0; ks < 2; ++ks) {
        bf16x8 a[2];
#pragma unroll
        for (int m2 = 0; m2 < 2; ++m2) a[m2] = cat4(vtr(Kimg + tr_addr(32 * ks + 8 * g4, 2 * w4 + m2, lane)), vtr(Kimg + tr_addr(32 * ks + 8 * g4 + 4, 2 * w4 + m2, lane)));
#pragma unroll
        for (int n = 0; n < 8; ++n) { const bf16x8 bv = cat4(vtr(Vimg + tr_addr(32 * ks + 8 * g4, n, lane)), vtr(Vimg + tr_addr(32 * ks + 8 * g4 + 4, n, lane)));
#pragma unroll
            for (int m2 = 0; m2 < 2; ++m2) acc[m2][n] = __builtin_amdgcn_mfma_f32_16x16x32_bf16(a[m2], bv, acc[m2][n], 0, 0, 0); }
#pragma unroll
        for (int m2 = 0; m2 < 2; ++m2) accn[m2] = __builtin_amdgcn_mfma_f32_16x16x32_bf16(a[m2], ones, accn[m2], 0, 0, 0);
    }
#pragma unroll
    for (int m2 = 0; m2 < 2; ++m2) { const int k0 = 16 * (2 * w4 + m2) + 4 * g4;
#pragma unroll
        for (int n = 0; n < 8; ++n) { const int v = 16 * n + (lane & 15); *(v2u*)(dC + ((size_t)unit * 128 + v) * 128 + k0) = (v2u){pk2(acc[m2][n][0], acc[m2][n][1]), pk2(acc[m2][n][2], acc[m2][n][3])}; }
        if ((lane & 15) == 0) *(f32x4*)(dn + (size_t)unit * 128 + k0) = accn[m2]; }
    __syncthreads();
}

__device__ __forceinline__ void mlstm_b(const Frame& F, bf16* dC, float* dn, float* msc) {
    LAS float* sa = (LAS float*)(F.lds); LAS float* sb = sa + 128; LAS float* fd = sa + 256; LAS float* iw = sa + 384; LAS float* mm = sa + 512;
    for (int e0 = F.vcu * NTHR; e0 < 8 * 16384; e0 += F.G * NTHR) {
        const int e = e0 + F.tid, bh = e0 >> 14, idx = e & 16383;
        if (F.tid < 128) { sa[F.tid] = msc[(bh * 128 + F.tid) * 4 + 0]; sb[F.tid] = msc[(bh * 128 + F.tid) * 4 + 1]; }
        __syncthreads();
        if (F.tid == 0) { float m = 0.f; for (int c = 0; c < 128; ++c) { const float mn = fmaxf(sb[c] + m, sa[c]); fd[c] = __expf(sb[c] + m - mn); iw[c] = __expf(sa[c] - mn); mm[c] = m; m = mn; } }
        __syncthreads();
        bf16* p = dC + (size_t)bh * 128 * 16384 + idx;
        float C = 0.f;
#pragma unroll 8
        for (int c = 0; c < 128; ++c) { const float d = bf2f(p[(size_t)c * 16384]); p[(size_t)c * 16384] = (bf16)f2bf(C); C = fd[c] * C + iw[c] * d; }
        if (idx < 128) { float* q = dn + (size_t)bh * 128 * 128 + idx; float nn = 0.f;
#pragma unroll 8
            for (int c = 0; c < 128; ++c) { const float d = q[c * 128]; q[c * 128] = nn; nn = fd[c] * nn + iw[c] * d; } }
        if (idx == 0) for (int c = 0; c < 128; ++c) msc[(bh * 128 + c) * 4 + 2] = mm[c];
        __syncthreads();
    }
}

__device__ __forceinline__ void mlstm_c_pair(const Frame& F, int pair, const bf16* qkvo, const float* gates, const float* conv_w, const float* conv_b, const bf16* Cst, const float* nst, const float* msc, const float* ng, bf16* merged) {
    const int hb = F.wave >> 2, w4 = F.wave & 3, tid4 = F.tid & 255, lane = F.lane, g4 = lane >> 4, l15 = lane & 15;
    const int unit = 2 * pair + hb, bh = unit >> 7, c = unit & 127, b = bh >> 2, h = bh & 3, t0 = b * L + c * 64;
    LAS unsigned char* Kimg = F.lds + hb * 65536; LAS unsigned char* Vimg = Kimg + 16384; LAS unsigned char* Cimg = Kimg + 32768; LAS unsigned char* Qimg = Cimg;
    LAS float* gl = (LAS float*)(F.lds + LDS_AUX + hb * 4096); LAS float* bcl = gl + 64; LAS float* nl = gl + 128;
    float bcs, g; chunk_gates(gates, t0, h, lane, bcs, g);
    if (w4 == 0) { gl[lane] = g; bcl[lane] = bcs; }
    const float mc = msc[unit * 4 + 2];
    const int d8 = tid4 & 15, rg = tid4 >> 4;
    { v4u kc[4]; conv4x8(qkvo + (size_t)1 * T * 512 + (size_t)(t0 + 4 * rg) * 512 + h * 128 + 8 * d8, c * 64 + 4 * rg, conv_w + 512 + h * 128 + 8 * d8, conv_b + 512 + h * 128 + 8 * d8, 0.08838834764831845f, kc);
#pragma unroll
      for (int r = 0; r < 4; ++r) *(LAS v4u*)(Kimg + off_b(4 * rg + r, d8)) = kc[r]; }
    { v4u qc[4]; conv4x8(qkvo + (size_t)(t0 + 4 * rg) * 512 + h * 128 + 8 * d8, c * 64 + 4 * rg, conv_w + h * 128 + 8 * d8, conv_b + h * 128 + 8 * d8, 1.0f, qc);
#pragma unroll
      for (int r = 0; r < 4; ++r) *(LAS v4u*)(Qimg + off_b(4 * rg + r, d8)) = qc[r]; }
#pragma unroll
    for (int r = 0; r < 4; ++r) *(LAS v4u*)(Vimg + off_b(4 * rg + r, d8)) = *(const v4u*)(qkvo + (size_t)2 * T * 512 + (size_t)(t0 + 4 * rg + r) * 512 + h * 128 + 8 * d8);
    if (tid4 < 128) nl[tid4] = nst[(size_t)unit * 128 + tid4];
    v4u creg[8];
#pragma unroll
    for (int i = 0; i < 8; ++i) creg[i] = *(const v4u*)(Cst + (size_t)unit * 16384 + (size_t)(tid4 + 256 * i) * 8);
    __syncthreads();
    const int jl = 16 * w4 + l15;
    bf16x8 qf[4];
#pragma unroll
    for (int kk = 0; kk < 4; ++kk) qf[kk] = *(const LAS bf16x8*)(Qimg + off_b(jl, 4 * kk + g4));
    float M = mc;
    for (int s = 0; s < 64; ++s) { const float gs = gl[s]; M = (s <= jl) ? fmaxf(M, gs) : M; }
    const float winter = __expf(mc - M);
    v2u sb[4];
#pragma unroll
    for (int st = 0; st < 4; ++st) {
        f32x4 a4 = (f32x4){0.f, 0.f, 0.f, 0.f};
#pragma unroll
        for (int kk = 0; kk < 4; ++kk) { const bf16x8 ka = *(const LAS bf16x8*)(Kimg + off_b(16 * st + l15, 4 * kk + g4)); a4 = __builtin_amdgcn_mfma_f32_16x16x32_bf16(ka, qf[kk], a4, 0, 0, 0); }
        const f32x4 gs = *(const LAS f32x4*)(gl + 16 * st + 4 * g4);
        float vv[4];
#pragma unroll
        for (int r = 0; r < 4; ++r) { const int s = 16 * st + 4 * g4 + r; vv[r] = (s <= jl) ? a4[r] * __expf(gs[r] - M) : 0.f; }
        sb[st] = (v2u){pk2(vv[0], vv[1]), pk2(vv[2], vv[3])};
    }
    __syncthreads();
#pragma unroll
    for (int i = 0; i < 8; ++i) { const int q = tid4 + 256 * i; *(LAS v4u*)(Cimg + off_b(q >> 4, q & 15)) = creg[i]; }
    __syncthreads();
    f32x4 ai[9], ae[9];
#pragma unroll
    for (int vt = 0; vt < 9; ++vt) { ai[vt] = (f32x4){0.f, 0.f, 0.f, 0.f}; ae[vt] = (f32x4){0.f, 0.f, 0.f, 0.f}; }
    bf16x8 ones; { const short o = (l15 == 0) ? (short)0x3F80 : (short)0;
#pragma unroll
        for (int j = 0; j < 8; ++j) ones[j] = o; }
#pragma unroll
    for (int ks = 0; ks < 2; ++ks) {
        bf16x8 bs; { const v4u t4 = (v4u){sb[2 * ks].x, sb[2 * ks].y, sb[2 * ks + 1].x, sb[2 * ks + 1].y}; bs = __builtin_bit_cast(bf16x8, t4); }
#pragma unroll
        for (int vt = 0; vt < 8; ++vt) { const bf16x8 va = cat4(vtr(Vimg + tr_addr(32 * ks + 4 * g4, vt, lane)), vtr(Vimg + tr_addr(32 * ks + 16 + 4 * g4, vt, lane)));
            ai[vt] = __builtin_amdgcn_mfma_f32_16x16x32_bf16(va, bs, ai[vt], 0, 0, 0); }
        ai[8] = __builtin_amdgcn_mfma_f32_16x16x32_bf16(ones, bs, ai[8], 0, 0, 0);
    }
#pragma unroll
    for (int kk = 0; kk < 4; ++kk) {
#pragma unroll
        for (int vt = 0; vt < 8; ++vt) { const bf16x8 ca = *(const LAS bf16x8*)(Cimg + off_b(16 * vt + l15, 4 * kk + g4)); ae[vt] = __builtin_amdgcn_mfma_f32_16x16x32_bf16(ca, qf[kk], ae[vt], 0, 0, 0); }
        bf16x8 na; { const f32x4 n0 = *(const LAS f32x4*)(nl + 32 * kk + 8 * g4), n1 = *(const LAS f32x4*)(nl + 32 * kk + 8 * g4 + 4);
            const v4u t4 = (l15 == 0) ? (v4u){pk2(n0.x, n0.y), pk2(n0.z, n0.w), pk2(n1.x, n1.y), pk2(n1.z, n1.w)} : (v4u){0u, 0u, 0u, 0u}; na = __builtin_bit_cast(bf16x8, t4); }
        ae[8] = __builtin_amdgcn_mfma_f32_16x16x32_bf16(na, qf[kk], ae[8], 0, 0, 0);
    }
    float den = ai[8][0] + winter * ae[8][0];
    den = __shfl(den, l15);
    const float mrow = bcl[jl] + M;
    const float inv = 1.f / fmaxf(fabsf(den), __expf(-mrow));
    float hv[8][4]; float ss = 0.f;
#pragma unroll
    for (int vt = 0; vt < 8; ++vt)
#pragma unroll
        for (int r = 0; r < 4; ++r) { const float x = (ai[vt][r] + winter * ae[vt][r]) * inv; hv[vt][r] = x; ss += x * x; }
    ss += __shfl_xor(ss, 16); ss += __shfl_xor(ss, 32);
    const float rs = rsqrtf(ss * (1.f / 128.f) + EPS);
    const size_t tok = (size_t)(t0 + jl);
#pragma unroll
    for (int vt = 0; vt < 8; ++vt) { const int col = h * 128 + 16 * vt + 4 * g4;
        const v2u ov = *(const v2u*)(qkvo + (size_t)3 * T * 512 + tok * 512 + col); const f32x4 gg = *(const f32x4*)(ng + col);
        const float o0 = sigmoidf_(bf2f(ov.x & 0xffffu)) * (hv[vt][0] * rs * gg.x), o1 = sigmoidf_(bf2f(ov.x >> 16)) * (hv[vt][1] * rs * gg.y);
        const float o2 = sigmoidf_(bf2f(ov.y & 0xffffu)) * (hv[vt][2] * rs * gg.z), o3 = sigmoidf_(bf2f(ov.y >> 16)) * (hv[vt][3] * rs * gg.w);
        *(v2u*)(merged + tok * D + col) = (v2u){pk2(o0, o1), pk2(o2, o3)}; }
    __syncthreads();
}

__device__ __forceinline__ void s5_gen(const Frame& F, int g, const float* lam_re, const float* lam_im, const float* log_dt, const float* b_re, const float* b_im, const float* c_re, const float* c_im, const float* dsk, bf16* TQ, bf16* PG, float* a32) {
    LAS float* apr = (LAS float*)F.lds; LAS float* api = apr + 33 * 64; LAS float* bbr = api + 33 * 64; LAS float* bbi = bbr + 1024; LAS float* cre = bbi + 1024; LAS float* cim = cre + 1024; LAS float* ktab = cim + 1024;
    const int tid = F.tid;
    if (tid < 64) { const int n = tid, gi = g * SN + n;
        const float lr = fminf(lam_re[gi], -1e-4f), li = lam_im[gi], dt = expf(log_dt[g]);
        for (int p = 0; p <= 32; ++p) { const float mag = expf((float)p * lr * dt); float sn, cs; sincosf((float)p * li * dt, &sn, &cs); apr[p * 64 + n] = mag * cs; api[p * 64 + n] = mag * sn; }
        const float ar = apr[64 + n], ai = api[64 + n], den = lr * lr + li * li;
        const float cr = ((ar - 1.f) * lr + ai * li) / den, ci = (ai * lr - (ar - 1.f) * li) / den;
        for (int hh = 0; hh < 16; ++hh) { const float br = b_re[gi * 16 + hh], bi = b_im[gi * 16 + hh]; bbr[n * 16 + hh] = cr * br - ci * bi; bbi[n * 16 + hh] = cr * bi + ci * br; }
        a32[gi * 2] = apr[32 * 64 + n]; a32[gi * 2 + 1] = api[32 * 64 + n]; }
    for (int i = tid; i < 1024; i += NTHR) { cre[i] = c_re[g * 1024 + i]; cim[i] = c_im[g * 1024 + i]; }
    __syncthreads();
    for (int i = tid; i < 32 * 256; i += NTHR) { const int tau = i >> 8, hh = (i >> 4) & 15, hp = i & 15; float a = 0.f;
        for (int n = 0; n < 64; ++n) { const float xr = cre[hh * 64 + n] * apr[tau * 64 + n] - cim[hh * 64 + n] * api[tau * 64 + n], xi = cre[hh * 64 + n] * api[tau * 64 + n] + cim[hh * 64 + n] * apr[tau * 64 + n];
            a += xr * bbr[n * 16 + hp] - xi * bbi[n * 16 + hp]; }
        if (tau == 0 && hh == hp) a += dsk[g * 16 + hh];
        ktab[i] = a; }
    __syncthreads();
    bf16* tq = TQ + (size_t)g * 512 * AGK; bf16* pg = PG + (size_t)g * 128 * 512;
    for (int i = tid; i < 512 * 80; i += NTHR) { const int row = i / 80, k0 = (i % 80) * 8, j = row >> 4, hh = row & 15; float o[8];
        if (k0 < 512) { const int ii = k0 >> 4, hp0 = k0 & 15, tau = j - ii;
#pragma unroll
            for (int q = 0; q < 8; ++q) o[q] = (tau >= 0) ? ktab[tau * 256 + hh * 16 + hp0 + q] : 0.f; }
        else { const int im = (k0 >= 576), n0 = (k0 - 512) & 63;
#pragma unroll
            for (int q = 0; q < 8; ++q) { const int n = n0 + q; const float pr = apr[(j + 1) * 64 + n], pi = api[(j + 1) * 64 + n], cr = cre[hh * 64 + n], ci = cim[hh * 64 + n];
                o[q] = im ? -(cr * pi + ci * pr) : (cr * pr - ci * pi); } }
        *(v4u*)(tq + (size_t)row * AGK + k0) = (v4u){pk2(o[0], o[1]), pk2(o[2], o[3]), pk2(o[4], o[5]), pk2(o[6], o[7])}; }
    for (int i = tid; i < 128 * 64; i += NTHR) { const int row = i >> 6, k0 = (i & 63) * 8, im = row >> 6, n = row & 63, ii = k0 >> 4, hp0 = k0 & 15; float o[8];
        const float pr = apr[(31 - ii) * 64 + n], pi = api[(31 - ii) * 64 + n];
#pragma unroll
        for (int q = 0; q < 8; ++q) { const float br = bbr[n * 16 + hp0 + q], bi = bbi[n * 16 + hp0 + q]; o[q] = im ? (pr * bi + pi * br) : (pr * br - pi * bi); }
        *(v4u*)(pg + (size_t)row * 512 + k0) = (v4u){pk2(o[0], o[1]), pk2(o[2], o[3]), pk2(o[4], o[5]), pk2(o[6], o[7])}; }
    __syncthreads();
}

__device__ __forceinline__ void s5_scan(const Frame& F, int bg, const float* E, const float* a32, bf16* ag) {
    const int b = bg >> 5, g = bg & 31, n = F.lane, w = F.wave;
    LAS float* ex = (LAS float*)F.lds;
    const float ar = a32[(g * 64 + n) * 2], ai = a32[(g * 64 + n) * 2 + 1];
    const size_t ch0 = (size_t)g * NCH + b * 256 + w * 32;
    float er[32], ei[32];
#pragma unroll
    for (int c = 0; c < 32; ++c) { er[c] = E[(ch0 + c) * 128 + n]; ei[c] = E[(ch0 + c) * 128 + 64 + n]; }
    float sr = 0.f, si = 0.f;
#pragma unroll
    for (int c = 0; c < 32; ++c) { const float nr = ar * sr - ai * si + er[c], ni = ar * si + ai * sr + ei[c]; sr = nr; si = ni; }
    ex[(w * 64 + n) * 2] = sr; ex[(w * 64 + n) * 2 + 1] = si;
    float pr = ar, pi = ai;
#pragma unroll
    for (int q = 0; q < 5; ++q) { const float t = pr * pr - pi * pi; pi = 2.f * pr * pi; pr = t; }
    __syncthreads();
    sr = 0.f; si = 0.f;
    for (int ww = 0; ww < w; ++ww) { const float xr = ex[(ww * 64 + n) * 2], xi = ex[(ww * 64 + n) * 2 + 1]; const float nr = pr * sr - pi * si + xr, ni = pr * si + pi * sr + xi; sr = nr; si = ni; }
#pragma unroll
    for (int c = 0; c < 32; ++c) { bf16* row = ag + (ch0 + c) * AGK + 512; row[n] = (bf16)f2bf(sr); row[64 + n] = (bf16)f2bf(si);
        const float nr = ar * sr - ai * si + er[c], ni = ar * si + ai * sr + ei[c]; sr = nr; si = ni; }
    __syncthreads();
}

__device__ __forceinline__ void s5_post(const Frame& F, int gw, int NGW, const bf16* y5, const float* glu_w, const float* glu_b, bf16* merged) {
    const int lane = F.lane, l31 = lane & 31, half = lane >> 5;
    for (int g = gw & 31; g < 32; g += 32) {
        bf16x8 af; { float a[8];
#pragma unroll
            for (int j = 0; j < 8; ++j) a[j] = glu_w[(size_t)(g * 16 + 8 * half + j) * 32 + l31];
            const v4u t4 = (v4u){pk2(a[0], a[1]), pk2(a[2], a[3]), pk2(a[4], a[5]), pk2(a[6], a[7])}; af = __builtin_bit_cast(bf16x8, t4); }
        f32x16 bias;
#pragma unroll
        for (int r = 0; r < 16; ++r) bias[r] = glu_b[g * 32 + (r & 3) + 8 * (r >> 2) + 4 * half];
        for (int tb = gw >> 5; tb < T / 32; tb += NGW >> 5) {
            const size_t tok = (size_t)tb * 32 + l31;
            const v4u yv = *(const v4u*)(y5 + tok * 512 + g * 16 + 8 * half);
            float y[8];
#pragma unroll
            for (int q = 0; q < 4; ++q) { y[2 * q] = gelu_tanh(bf2f(yv[q] & 0xffffu)); y[2 * q + 1] = gelu_tanh(bf2f(yv[q] >> 16)); }
            const v4u t4 = (v4u){pk2(y[0], y[1]), pk2(y[2], y[3]), pk2(y[4], y[5]), pk2(y[6], y[7])};
            const f32x16 z = __builtin_amdgcn_mfma_f32_32x32x16_bf16(af, __builtin_bit_cast(bf16x8, t4), bias, 0, 0, 0);
            float o[8];
#pragma unroll
            for (int r = 0; r < 8; ++r) o[r] = z[r] * sigmoidf_(z[r + 8]);
            bf16* dst = merged + tok * D + 512 + g * 16 + 4 * half;
            *(v2u*)dst = (v2u){pk2(o[0], o[1]), pk2(o[2], o[3])};
            *(v2u*)(dst + 8) = (v2u){pk2(o[4], o[5]), pk2(o[6], o[7])};
        }
    }
}

struct S5ESched {
    const bf16* AG; const bf16* PG; int K, lda, ldb, G, c, reps;
    __device__ __forceinline__ bool next(int i, pg8::Unit& u) const { int Lx = i * G + c; if (Lx >= 64 * reps) return false; Lx &= 63; u.e = Lx >> 1; u.pm = Lx & 1; u.pn = 0; u.rows = 256; u.slot0 = 0; u.lidx = i; return true; }
    __device__ __forceinline__ const char* a_ptr(const pg8::Unit& u) const { return (const char*)(AG + (size_t)u.e * NCH * AGK); }
    __device__ __forceinline__ const char* b_ptr(const pg8::Unit& u) const { return (const char*)(PG + (size_t)u.e * 128 * 512); }
    __device__ __forceinline__ int a_row(const pg8::Unit& u, int r) const { return u.pm * 256 + r; }
};
struct EpiS5E {
    static constexpr bool PERM = false;
    float* E;
    __device__ __forceinline__ void operator()(const f32x4 (&acc)[2][2][4][2], const pg8::Unit& u, int wr, int wc, int fr, int fq) const {
#pragma unroll
        for (int ai = 0; ai < 2; ++ai)
#pragma unroll
            for (int m = 0; m < 4; ++m) { const int chunk = u.pm * 256 + ai * 128 + wr * 64 + m * 16 + fr;
#pragma unroll
                for (int n = 0; n < 2; ++n) *(f32x4*)(E + ((size_t)u.e * NCH + chunk) * 128 + wc * 32 + 16 * n + 4 * fq) = acc[ai][0][m][n]; }
    }
};
struct S5YSched {
    const bf16* AG; const bf16* TQ; int K, lda, ldb, G, c, reps;
    __device__ __forceinline__ bool next(int i, pg8::Unit& u) const { int Lx = i * G + c; if (Lx >= 128 * reps) return false; Lx &= 127; u.e = Lx >> 2; u.pm = (Lx >> 1) & 1; u.pn = Lx & 1; u.rows = 256; u.slot0 = 0; u.lidx = i; return true; }
    __device__ __forceinline__ const char* a_ptr(const pg8::Unit& u) const { return (const char*)(AG + (size_t)u.e * NCH * AGK); }
    __device__ __forceinline__ const char* b_ptr(const pg8::Unit& u) const { return (const char*)(TQ + (size_t)u.e * 512 * AGK + (size_t)u.pn * 256 * AGK); }
    __device__ __forceinline__ int a_row(const pg8::Unit& u, int r) const { return u.pm * 256 + r; }
};
struct EpiS5Y {
    static constexpr bool PERM = true;
    bf16* y5;
    __device__ __forceinline__ void operator()(const f32x4 (&acc)[2][2][4][2], const pg8::Unit& u, int wr, int wc, int fr, int fq) const {
#pragma unroll
        for (int ai = 0; ai < 2; ++ai)
#pragma unroll
            for (int m = 0; m < 4; ++m) { const int chunk = u.pm * 256 + ai * 128 + wr * 64 + m * 16 + fr;
#pragma unroll
                for (int bj = 0; bj < 2; ++bj) { const f32x4 v0 = acc[ai][bj][m][0], v1 = acc[ai][bj][m][1];
                    v4u w; w.x = pg8::cvt_pk_bf16(v0[0], v0[1]); w.y = pg8::cvt_pk_bf16(v0[2], v0[3]); w.z = pg8::cvt_pk_bf16(v1[0], v1[1]); w.w = pg8::cvt_pk_bf16(v1[2], v1[3]);
                    const int np = u.pn * 256 + bj * 128 + wc * 32 + 8 * fq, j = np >> 4, h0 = np & 15;
                    *(v4u*)(y5 + ((size_t)chunk * 32 + j) * 512 + u.e * 16 + h0) = w; } }
    }
};

__global__ void __launch_bounds__(NTHR, 2) mk_fwd(Args args) {
    extern __shared__ __attribute__((aligned(16))) unsigned char lds_raw[];
    Frame F;
    F.lds = (LAS unsigned char*)lds_raw; F.MISC = (volatile LAS unsigned*)(F.lds + MISC_OFF);
    F.tid = threadIdx.x; F.lane = F.tid & 63; F.wave = __builtin_amdgcn_readfirstlane(F.tid >> 6);
    F.G = gridDim.x; { const int bx = blockIdx.x; F.vcu = (F.G % 8 == 0) ? (bx % 8) * (F.G / 8) + bx / 8 : bx; }
    F.ws = args.ws; F.ctl = (unsigned*)(args.ws + WS_CTL);
    unsigned char* ws = args.ws;
    const int lo = args.ph_lo, hi = args.ph_hi;
    for (int u = F.tid; u < 64; u += NTHR) ((LAS unsigned*)(F.lds + MISC_OFF))[u] = 0u;
    __syncthreads();
    XcdBarrier bar = xcd_barrier_post(F.ctl + CW_BAR, F.MISC + 8);
#define IN(k) (lo <= (k) && (k) < hi)
#ifndef MK_PROBE_A
#define MK_PROBE_A -1
#define MK_PROBE_B -1
#define MK_PROBE_SCALE 1.0f
#endif
#ifndef MK_DBL
#define MK_DBL -1
#endif
#define REPS(k) ((MK_DBL == (k)) ? 2 : 1)
#define STAMP(k) do { if (MK_PROBE_A >= 0 && blockIdx.x == 0 && F.tid == 0) F.MISC[16 + (k)] = (unsigned)__builtin_amdgcn_s_memrealtime(); } while (0)
#define SEAM(k) do { if (IN(k) && IN((k) + 1)) xcd_barrier(bar); STAMP((k) + 1); } while (0)
    const int gw = F.vcu * NWAVES + F.wave, NGW = F.G * NWAVES;
    STAMP(0);
    const float* x = args.in[0];
    bf16* xb = (bf16*)(ws + WS_XB);
    float* gates = (float*)(ws + WS_GATES);

    if (IN(0)) for (int rep = 0; rep < REPS(0); ++rep) { if (rep) xcd_barrier(bar);
        const float* g1 = args.in[1]; const float* w_in = args.in[2]; const float* w_out = args.in[18];
        LAS float* wg = (LAS float*)(F.lds);
        for (int i = F.tid; i < 1024 * 8; i += NTHR) { const int k = i >> 3, c = i & 7; wg[i] = w_in[(size_t)k * NP + 2048 + c] * g1[k]; }
        __syncthreads();
        const float* ib = args.in[5]; const float* fb = args.in[6];
        for (int m = gw; m < T; m += NGW) {
            const GAS f32x4* xr = (const GAS f32x4*)(x + (size_t)m * D) + F.lane;
            f32x4 v[4]; float s = 0.f;
#pragma unroll
            for (int j = 0; j < 4; ++j) { v[j] = xr[64 * j]; s += (v[j].x * v[j].x + v[j].y * v[j].y) + (v[j].z * v[j].z + v[j].w * v[j].w); }
            const float rs = rsqrtf(wave_sum(s) * (1.f / D) + EPS);
            float d[8] = {};
#pragma unroll
            for (int j = 0; j < 4; ++j) {
#pragma unroll
                for (int q = 0; q < 4; ++q) { const int k = 4 * F.lane + 256 * j + q; const f32x4 w0 = *(const LAS f32x4*)(wg + k * 8), w1 = *(const LAS f32x4*)(wg + k * 8 + 4); const float xv = v[j][q] * rs;
                    d[0] += xv * w0.x; d[1] += xv * w0.y; d[2] += xv * w0.z; d[3] += xv * w0.w; d[4] += xv * w1.x; d[5] += xv * w1.y; d[6] += xv * w1.z; d[7] += xv * w1.w; } }
#pragma unroll
            for (int c = 0; c < 8; ++c) d[c] = wave_sum(d[c]);
            GAS unsigned long long* o8 = (GAS unsigned long long*)(xb + (size_t)m * D) + F.lane;
#pragma unroll
            for (int j = 0; j < 4; ++j) o8[64 * j] = (unsigned long long)pk2(v[j].x * rs, v[j].y * rs) | ((unsigned long long)pk2(v[j].z * rs, v[j].w * rs) << 32);
            if (F.lane < 8) { const int c = F.lane; float val = 0.f;
#pragma unroll
                for (int q = 0; q < 8; ++q) val = (c == q) ? d[q] : val;
                val = (c < 4) ? (val + ib[c & 3]) : log_sigmoidf_(val + fb[c & 3]); gates[(size_t)m * 8 + c] = val; }
        }
        __syncthreads();
        LAS unsigned char* scr = F.lds + F.wave * 8192;
        constexpr int I_IN = (D / 64) * (2560 / 64), I_OUT = (D / 64) * (D / 64);
        for (int it = gw; it < I_IN + I_OUT; it += NGW) {
            if (it < I_IN) { const int kb = it / 40, nb = it % 40, n0 = nb * 64; tconv64(w_in, NP, kb * 64, n0 < 2048 ? n0 : n0 + 8, (bf16*)(ws + WS_WIN), D, n0, g1, scr, F.lane); }
            else { const int r = it - I_IN, kb = r / 16, nb = r % 16; tconv64(w_out, D, kb * 64, nb * 64, (bf16*)(ws + WS_WOUT), D, nb * 64, nullptr, scr, F.lane); }
        }
    }
    if (IN(0)) {
        const float* g2 = args.in[19]; const float* rgw = args.in[20]; const float* rew = args.in[22];
        bf16* wrh = (bf16*)(ws + WS_WRH); bf16* wrl = (bf16*)(ws + WS_WRL);
        for (int i = F.vcu * NTHR + F.tid; i < 48 * 1024; i += F.G * NTHR) { const int c = i >> 10, k = i & 1023;
            const float w = (c < 4) ? rgw[k * 4 + c] * g2[k] : (c < 36) ? rew[k * 32 + (c - 4)] * g2[k] : 0.f;
            const unsigned h = f2bf(w); wrh[i] = (bf16)h; wrl[i] = (bf16)f2bf(w - bf2f(h)); }
    }
    if (IN(0)) { __syncthreads();
        for (int g = F.vcu; g < SG; g += F.G) s5_gen(F, g, args.in[8], args.in[9], args.in[10], args.in[11], args.in[12], args.in[13], args.in[14], args.in[15], (bf16*)(ws + WS_TQ), (bf16*)(ws + WS_PG), (float*)(ws + WS_S5PAR)); }
    SEAM(0);
    if (IN(1)) {
        DenseSched S; S.init(xb, (const bf16*)(ws + WS_WIN), T, 2560, D, D, D, F.G, (int)blockIdx.x); S.reps = REPS(1);
        EpiInProj E{(bf16*)(ws + WS_QKVO), (bf16*)(ws + WS_AG)};
        pg8::gemm_phase<EpiInProj, DenseSched>(F.lds, S, E);
    }
    SEAM(1);
    if (IN(2)) {
        { S5ESched S; S.AG = (const bf16*)(ws + WS_AG); S.PG = (const bf16*)(ws + WS_PG); S.K = 512; S.lda = AGK; S.ldb = 512; S.G = F.G; S.c = (int)blockIdx.x; S.reps = REPS(20);
          EpiS5E E{(float*)(ws + WS_EE)};
          pg8::gemm_phase<EpiS5E, S5ESched>(F.lds, S, E); }
        __syncthreads();
        for (int p = F.vcu; p < 512 * REPS(2); p += F.G) mlstm_a_pair(F, p & 511, (const bf16*)(ws + WS_QKVO), gates, args.in[3], args.in[4], (bf16*)(ws + WS_DC), (float*)(ws + WS_DN), (float*)(ws + WS_MSC));
    }
    SEAM(2);
    if (IN(3)) {
        for (int bg = F.vcu; bg < 64; bg += F.G) s5_scan(F, bg, (const float*)(ws + WS_EE), (const float*)(ws + WS_S5PAR), (bf16*)(ws + WS_AG));
        __syncthreads();
        mlstm_b(F, (bf16*)(ws + WS_DC), (float*)(ws + WS_DN), (float*)(ws + WS_MSC));
    }
    SEAM(3);
    if (IN(4)) {
        { S5YSched S; S.AG = (const bf16*)(ws + WS_AG); S.TQ = (const bf16*)(ws + WS_TQ); S.K = AGK; S.lda = AGK; S.ldb = AGK; S.G = F.G; S.c = (int)blockIdx.x; S.reps = REPS(40);
          EpiS5Y E{(bf16*)(ws + WS_Y5)};
          pg8::gemm_phase<EpiS5Y, S5YSched>(F.lds, S, E); }
        __syncthreads();
        for (int p = F.vcu; p < 512 * REPS(4); p += F.G) mlstm_c_pair(F, p & 511, (const bf16*)(ws + WS_QKVO), gates, args.in[3], args.in[4], (const bf16*)(ws + WS_DC), (const float*)(ws + WS_DN), (const float*)(ws + WS_MSC), args.in[7], xb);
    }
    SEAM(4);
    if (IN(5)) for (int rep = 0; rep < REPS(5); ++rep) { if (rep) xcd_barrier(bar); s5_post(F, gw, NGW, (const bf16*)(ws + WS_Y5), args.in[16], args.in[17], xb); }
    SEAM(5);
    if (IN(6)) {
        DenseSched S; S.init(xb  , (const bf16*)(ws + WS_WOUT), T, D, D, D, D, F.G, (int)blockIdx.x); S.reps = REPS(6);
        EpiResF32 E{x, args.out};
        pg8::gemm_phase<EpiResF32, DenseSched>(F.lds, S, E);
    }
    SEAM(6);
    if (IN(7)) {
        const float* g2 = args.in[19]; const float* rgw = args.in[20]; const float* rgb = args.in[21]; const float* rew = args.in[22]; const float* reb = args.in[23];
        float* rs2o = (float*)(ws + WS_RS2); int* tok_e = (int*)(ws + WS_TOKE); float* tok_w = (float*)(ws + WS_TOKW); int* tok_p = (int*)(ws + WS_TOKP); int* list = (int*)(ws + WS_LIST);
        unsigned* cnt = F.ctl + CW_CNT; const float* x1 = args.out;
        const bf16* wrh = (const bf16*)(ws + WS_WRH); const bf16* wrl = (const bf16*)(ws + WS_WRL);
        LAS float* lg = (LAS float*)(F.lds + F.wave * 4096);
        for (int rt = gw; rt < T / 16; rt += NGW) {
            const int l15 = F.lane & 15, g4 = F.lane >> 4, row = rt * 16 + l15;
            const float* xr = x1 + (size_t)row * D + 8 * g4; bf16* xo = xb + (size_t)row * D + 8 * g4;
            const bf16* bh = wrh + (size_t)l15 * D + 8 * g4; const bf16* bl = wrl + (size_t)l15 * D + 8 * g4;
            f32x4 acc[3]; acc[0] = acc[1] = acc[2] = (f32x4){0.f, 0.f, 0.f, 0.f}; float ss = 0.f;
#pragma unroll 4
            for (int ks = 0; ks < 32; ++ks) {
                const f32x4 a0 = *(const f32x4*)(xr + 32 * ks), a1 = *(const f32x4*)(xr + 32 * ks + 4);
                const float av[8] = {a0.x, a0.y, a0.z, a0.w, a1.x, a1.y, a1.z, a1.w};
                unsigned hb[8], lb[8];
#pragma unroll
                for (int j = 0; j < 8; ++j) { ss += av[j] * av[j]; hb[j] = f2bf(av[j]); lb[j] = f2bf(av[j] - bf2f(hb[j])); }
                const v4u ah4 = (v4u){hb[0] | (hb[1] << 16), hb[2] | (hb[3] << 16), hb[4] | (hb[5] << 16), hb[6] | (hb[7] << 16)};
                const v4u al4 = (v4u){lb[0] | (lb[1] << 16), lb[2] | (lb[3] << 16), lb[4] | (lb[5] << 16), lb[6] | (lb[7] << 16)};
                *(v4u*)(xo + 32 * ks) = ah4;
                const bf16x8 ah = __builtin_bit_cast(bf16x8, ah4), al = __builtin_bit_cast(bf16x8, al4);
#pragma unroll
                for (int ct = 0; ct < 3; ++ct) { const bf16x8 wh = *(const bf16x8*)(bh + (size_t)ct * 16 * D + 32 * ks), wl = *(const bf16x8*)(bl + (size_t)ct * 16 * D + 32 * ks);
                    acc[ct] = __builtin_amdgcn_mfma_f32_16x16x32_bf16(ah, wh, acc[ct], 0, 0, 0);
                    acc[ct] = __builtin_amdgcn_mfma_f32_16x16x32_bf16(al, wh, acc[ct], 0, 0, 0);
                    acc[ct] = __builtin_amdgcn_mfma_f32_16x16x32_bf16(ah, wl, acc[ct], 0, 0, 0); }
            }
            ss += __shfl_xor(ss, 16); ss += __shfl_xor(ss, 32);
            const float rs = rsqrtf(ss * (1.f / D) + EPS);
#pragma unroll
            for (int r = 0; r < 4; ++r) { const float rr = __shfl(rs, 4 * g4 + r);
#pragma unroll
                for (int ct = 0; ct < 3; ++ct) lg[(4 * g4 + r) * 48 + 16 * ct + l15] = acc[ct][r] * rr; }
            asm volatile("s_waitcnt lgkmcnt(0)" ::: "memory");
            if (F.lane < 16) {
                const int t = rt * 16 + F.lane; const LAS float* lr = lg + F.lane * 48;
                float gl[4];
#pragma unroll
                for (int c = 0; c < 4; ++c) gl[c] = lr[c] + rgb[c];
                int gi = 0; float gm = gl[0];
#pragma unroll
                for (int c = 1; c < 4; ++c) if (gl[c] > gm) { gm = gl[c]; gi = c; }
                float gs = 0.f;
#pragma unroll
                for (int c = 0; c < 4; ++c) gs += expf(gl[c] - gm);
                const float gwt = 1.f / gs;
                float el[8];
#pragma unroll
                for (int c = 0; c < 8; ++c) el[c] = lr[4 + gi * 8 + c] + reb[gi * 8 + c];
                int i0 = 0; float m0 = el[0];
#pragma unroll
                for (int c = 1; c < 8; ++c) if (el[c] > m0) { m0 = el[c]; i0 = c; }
                int i1 = 0; float m1 = -INFINITY;
#pragma unroll
                for (int c = 0; c < 8; ++c) if (c != i0 && el[c] > m1) { m1 = el[c]; i1 = c; }
                const float p1 = expf(m1 - m0);
                const float w0 = gwt / (1.f + p1), w1 = gwt * p1 / (1.f + p1);
                rs2o[t] = rs;
                const int e0 = gi * 8 + i0, e1 = gi * 8 + i1;
                const int p0 = (int)atomicAdd(&cnt[e0], 1u), p1i = (int)atomicAdd(&cnt[e1], 1u);
                list[e0 * T + p0] = t; list[e1 * T + p1i] = t;
                tok_e[2 * t] = e0; tok_e[2 * t + 1] = e1; tok_w[2 * t] = w0; tok_w[2 * t + 1] = w1; tok_p[2 * t] = p0; tok_p[2 * t + 1] = p1i;
            }
            asm volatile("s_waitcnt lgkmcnt(0)" ::: "memory");
        }
        __syncthreads();
        LAS unsigned char* scr = F.lds + F.wave * 8192;
        const float* Wg = args.in[24]; const float* Wu = args.in[25]; const float* Wd = args.in[26];
        bf16* wgu = (bf16*)(ws + WS_WGU); bf16* wd = (bf16*)(ws + WS_WD);
        for (int it0 = gw; it0 < NE * 384 * REPS(71); it0 += NGW) { const int it = it0 % (NE * 384);
            const int e = it / 384, r = it % 384;
            if (r < 256) { const int up = r >> 7, rr = r & 127, kb = rr >> 3, nb = rr & 7, n0 = nb * 64;
                const int drow = (n0 >> 7) * 256 + up * 128 + (n0 & 127);
                tconv64((up ? Wu : Wg) + (size_t)e * D * DE, DE, kb * 64, n0, wgu + (size_t)e * 1024 * 1024, D, drow, g2, scr, F.lane); }
            else { const int rr = r - 256, kb = rr >> 4, nb = rr & 15; tconv64(Wd + (size_t)e * DE * D, D, kb * 64, nb * 64, wd + (size_t)e * 1024 * 512, DE, nb * 64, nullptr, scr, F.lane); }
        }
    }
    SEAM(7);
    if (IN(8) || IN(9)) {
        LAS int* toff = (LAS int*)(F.lds + LDS_AUX); LAS int* soff = toff + 40; LAS int* tokl = toff + 128;
        if (F.tid == 0) { int a = 0, b = 0; for (int e = 0; e < NE; ++e) { const int c = (int)xb_ld(F.ctl + CW_CNT + e); toff[e] = a; soff[e] = b; a += (c + 255) >> 8; b += c; } toff[NE] = a; soff[NE] = b; }
        __syncthreads();
        MoeSched S; S.G = F.G; S.c = F.vcu; S.toff = toff; S.soff = soff; S.tokl = tokl; S.nunits = toff[NE] * 4; S.reps = 1;
        S.A = xb; S.Bt = (const bf16*)(ws + WS_WGU); S.K = D; S.lda = D; S.ldb = D; S.bstride = (size_t)1024 * 1024; S.gather = true;
        if (IN(8)) {
            const int* list = (const int*)(ws + WS_LIST); S.reps = REPS(8);
            for (int i = 0; i < MOE_MAXU; ++i) { pg8::Unit u; if (!S.next(i, u)) break; if (F.tid < 256) { const int r = min(F.tid, u.rows - 1); tokl[i * 256 + F.tid] = list[u.e * T + u.pm * 256 + r]; } }
            __syncthreads();
            S.reps = REPS(8);
            EpiGateUp E{(bf16*)(ws + WS_H), tokl, (const float*)(ws + WS_RS2)};
            pg8::gemm_phase<EpiGateUp, MoeSched>(F.lds, S, E);
        }
        SEAM(8);
        if (IN(9)) {
            S.A = (const bf16*)(ws + WS_H); S.Bt = (const bf16*)(ws + WS_WD); S.K = DE; S.lda = DE; S.ldb = DE; S.bstride = (size_t)1024 * 512; S.gather = false; S.reps = REPS(9);
            EpiDown E{(bf16*)(ws + WS_Y)};
            pg8::gemm_phase<EpiDown, MoeSched>(F.lds, S, E);
        }
    }
    SEAM(9);
    if (IN(10)) {
        LAS int* soff = (LAS int*)(F.lds + LDS_AUX) + 40;
        if (!IN(9)) { if (F.tid == 0) { int b = 0; for (int e = 0; e < NE; ++e) { soff[e] = b; b += (int)xb_ld(F.ctl + CW_CNT + e); } } __syncthreads(); }
        const float* gf = args.in[27]; const int* tok_e = (const int*)(ws + WS_TOKE); const float* tok_w = (const float*)(ws + WS_TOKW); const int* tok_p = (const int*)(ws + WS_TOKP);
        const bf16* Y = (const bf16*)(ws + WS_Y); float* out = args.out;
        for (int t = gw; t < T; t += NGW) {
            const int s0 = soff[tok_e[2 * t]] + tok_p[2 * t], s1 = soff[tok_e[2 * t + 1]] + tok_p[2 * t + 1]; const float w0 = tok_w[2 * t], w1 = tok_w[2 * t + 1];
            f32x4 v[4]; float s = 0.f;
#pragma unroll
            for (int j = 0; j < 4; ++j) {
                const f32x4 a = ((const GAS f32x4*)(out + (size_t)t * D) + F.lane)[64 * j];
                const v2u y0 = ((const GAS v2u*)(Y + (size_t)s0 * D) + F.lane)[64 * j], y1 = ((const GAS v2u*)(Y + (size_t)s1 * D) + F.lane)[64 * j];
                v[j].x = a.x + (w0 * bf2f(y0.x & 0xffffu) + w1 * bf2f(y1.x & 0xffffu)); v[j].y = a.y + (w0 * bf2f(y0.x >> 16) + w1 * bf2f(y1.x >> 16));
                v[j].z = a.z + (w0 * bf2f(y0.y & 0xffffu) + w1 * bf2f(y1.y & 0xffffu)); v[j].w = a.w + (w0 * bf2f(y0.y >> 16) + w1 * bf2f(y1.y >> 16));
                s += (v[j].x * v[j].x + v[j].y * v[j].y) + (v[j].z * v[j].z + v[j].w * v[j].w); }
            const float rs = rsqrtf(wave_sum(s) * (1.f / D) + EPS);
#pragma unroll
            for (int j = 0; j < 4; ++j) { const f32x4 gg = ((const GAS f32x4*)gf + F.lane)[64 * j]; ((GAS f32x4*)(out + (size_t)t * D) + F.lane)[64 * j] = (f32x4){v[j].x * rs * gg.x, v[j].y * rs * gg.y, v[j].z * rs * gg.z, v[j].w * rs * gg.w}; }
        }
    }
    if (MK_PROBE_A >= 0 && IN(10) && blockIdx.x == 0 && F.tid == 0) {
        STAMP(11);
        const unsigned dtk = F.MISC[16 + MK_PROBE_B] - F.MISC[16 + MK_PROBE_A];
        args.out[0] += (float)((dtk / 1600u) * 4u) * MK_PROBE_SCALE;
    }
#undef IN
#undef SEAM
}

extern "C" void kernel_launch(void* const* d_in, const int* in_sizes, int n_in, void* d_out, int out_size, void* d_ws, size_t ws_size, hipStream_t stream) {
    static int grid = 0;
    if (grid == 0) {
        int dev = 0, cus = 0, per_cu = 0;
        if (hipGetDevice(&dev) != hipSuccess || hipDeviceGetAttribute(&cus, hipDeviceAttributeMultiprocessorCount, dev) != hipSuccess) { grid = -1; return; }
        if (hipFuncSetAttribute((const void*)mk_fwd, hipFuncAttributeMaxDynamicSharedMemorySize, LDS_BYTES) != hipSuccess) { grid = -1; return; }
        if (hipOccupancyMaxActiveBlocksPerMultiprocessor(&per_cu, (const void*)mk_fwd, NTHR, LDS_BYTES) != hipSuccess || per_cu < 1) per_cu = 1;
        (void)hipGetLastError();
        grid = cus;
    }
    if (grid < 0) return;
    unsigned char* ws = (unsigned char*)d_ws;
    (void)hipMemsetAsync(ws + WS_CTL, 0, CTL_ZERO_BYTES, stream);
    Args a{};
    for (int i = 0; i < 28; ++i) a.in[i] = (const float*)d_in[i];
    a.out = (float*)d_out; a.ws = ws;
    auto launch = [&](int lo, int hi) { a.ph_lo = lo; a.ph_hi = hi; hipLaunchKernelGGL(mk_fwd, dim3(grid), dim3(NTHR), LDS_BYTES, stream, a); };
#ifndef MK_SPLIT
#define MK_SPLIT 0
#endif
    if (MK_SPLIT) { for (int p = 0; p < 11; ++p) launch(p, p + 1); }
    else launch(0, 11);
}
```

```cpp
#include <hip/hip_runtime.h>
#include <math.h>
#include <stdint.h>
#ifndef MK_PROBE_A
#define MK_PROBE_A -1
#define MK_PROBE_B -1
#define MK_PROBE_SCALE 1.0f
#endif

constexpr int T = 16384, L = 8192, D = 1024, NP = 2568;
constexpr int NH = 4, HD = 128;
constexpr int SG = 32, SC = 16, SN = 64;
constexpr int NE = 32, DE = 512;
constexpr float EPS = 1e-6f;
constexpr int LC = 32, NCH = T / LC;
constexpr int AGK = 640;

#define GAS __attribute__((address_space(1)))
#define LAS __attribute__((address_space(3)))
typedef unsigned short bf16;
typedef unsigned v4u __attribute__((ext_vector_type(4)));
typedef unsigned v2u __attribute__((ext_vector_type(2)));
typedef float f32x4 __attribute__((ext_vector_type(4)));
typedef float f32x2 __attribute__((ext_vector_type(2)));
typedef short bf16x8 __attribute__((ext_vector_type(8)));

__device__ __forceinline__ unsigned f2bf(float f) { unsigned u = __builtin_bit_cast(unsigned, f); return (u + 0x7fffu + ((u >> 16) & 1u)) >> 16; }
typedef __bf16 bf16x2_t __attribute__((ext_vector_type(2)));
__device__ __forceinline__ unsigned pk2(float lo, float hi) { const f32x2 v = {lo, hi}; const bf16x2_t b = __builtin_convertvector(v, bf16x2_t); return __builtin_bit_cast(unsigned, b); }
__device__ __forceinline__ float bf2f(unsigned b) { return __builtin_bit_cast(float, b << 16); }
__device__ __forceinline__ float wave_sum(float v) {
#pragma unroll
    for (int o = 1; o < 64; o <<= 1) v += __shfl_xor(v, o);
    return v;
}
__device__ __forceinline__ float sigmoidf_(float x) { return 1.f / (1.f + __expf(-x)); }
__device__ __forceinline__ float siluf_(float x) { return x / (1.f + __expf(-x)); }
__device__ __forceinline__ float log_sigmoidf_(float x) { return fminf(x, 0.f) - log1pf(expf(-fabsf(x))); }
__device__ __forceinline__ float gelu_tanh(float x) { const float u = 0.7978845608028654f * (x + 0.044715f * x * x * x); return x / (1.f + __expf(-2.f * u)); }

constexpr size_t MiB = 1u << 20;
constexpr size_t WS_CTL = 0, CTL_ZERO_BYTES = 64 * 1024;
constexpr size_t WS_WIN = 1 * MiB;
constexpr size_t WS_WOUT = 6 * MiB;
constexpr size_t WS_TQ = 8 * MiB;
constexpr size_t WS_PG = 28 * MiB;
constexpr size_t WS_SMALL = 33 * MiB;
constexpr size_t WS_GATES = WS_SMALL;
constexpr size_t WS_RS2 = WS_SMALL + 512 * 1024;
constexpr size_t WS_TOKE = WS_RS2 + 64 * 1024;
constexpr size_t WS_TOKW = WS_TOKE + 128 * 1024;
constexpr size_t WS_TOKP = WS_TOKW + 128 * 1024;
constexpr size_t WS_LIST = WS_SMALL + 1 * MiB;
constexpr size_t WS_S5PAR = WS_SMALL + 3 * MiB;
constexpr size_t WS_MSC = WS_SMALL + 3 * MiB + 64 * 1024;
constexpr size_t WS_DN = WS_SMALL + 4 * MiB;
constexpr size_t WS_WRH = WS_SMALL + 5 * MiB;
constexpr size_t WS_WRL = WS_SMALL + 5 * MiB + 128 * 1024;
constexpr size_t WS_XB = 40 * MiB;
constexpr size_t WS_QKVO = 72 * MiB;
constexpr size_t WS_DC = 136 * MiB;
constexpr size_t WS_WGU = 72 * MiB;
constexpr size_t WS_WD = 136 * MiB;
constexpr size_t WS_AG = 168 * MiB;
constexpr size_t WS_EE = 188 * MiB;
constexpr size_t WS_Y5 = 196 * MiB;
constexpr size_t WS_H = 168 * MiB;
constexpr size_t WS_Y = 201 * MiB;
constexpr size_t WS_END = 266 * MiB;
constexpr int CW_CNT = 1024;
constexpr int CW_BAR = 4096;

namespace pg8 {
typedef unsigned u32x4 __attribute__((ext_vector_type(4)));
constexpr int BM = 256, BK = 64, HALF = 128, HTB = HALF * BK * 2, STAGE_BYTES = 8 * HTB;
__host__ __device__ __forceinline__ int lds_byte(int r, int c) { const int st = (r >> 4) * 2 + (c >> 5), rr = r & 15, cc = c & 31, ob = rr * 64 + cc * 2; return st * 1024 + (ob ^ (((ob >> 9) & 1) << 5)); }
__host__ __device__ __forceinline__ void stage_rc(int b, int& R, int& C) { const int st = b / 1024, sb = b % 1024, swz = sb ^ (((sb >> 9) & 1) << 5); R = (st >> 1) * 16 + swz / 64; C = (st & 1) * 32 + (swz % 64) / 2; }
__host__ __device__ __forceinline__ int perm32(int rho) { const int n = rho >> 4, i = rho & 15; return 8 * (i >> 2) + 4 * n + (i & 3); }
__device__ __forceinline__ unsigned cvt_pk_bf16(float lo, float hi) { unsigned r; asm volatile("v_cvt_pk_bf16_f32 %0, %1, %2" : "=v"(r) : "v"(lo), "v"(hi)); return r; }

struct Unit { int pm, pn, e, rows, slot0, lidx; };

template <class Epi, class Sched, bool ALIGN_EPI = true>
__device__ __forceinline__ void gemm_phase(LAS unsigned char* lds, const Sched& S, const Epi& E) {
    const int tid = threadIdx.x, wid = __builtin_amdgcn_readfirstlane(tid >> 6), lane = tid & 63, wr = wid >> 2, wc = wid & 3, fr = lane & 15, fq = lane >> 4;
    const int K = S.K, nt = K / BK;
    int Rr[2], Cc[2];
    unsigned voffA[2][2], voffB[2], voffN[2][2];
#pragma unroll
    for (int i = 0; i < 2; ++i) { int R, C; stage_rc(tid * 16 + i * 8192, R, C); Rr[i] = R; Cc[i] = C; const int Rb = Epi::PERM ? ((R & ~31) + perm32(R & 31)) : R;
        voffB[i] = (unsigned)(Rb * S.ldb + C) * 2u; }
    const size_t kstep = (size_t)(BK * 2);
    const size_t hstepB = (size_t)HALF * S.ldb * 2;
    const unsigned ldsw = (unsigned)wid * 1024u;
    const int aoff = lds_byte(wr * 64 + fr, fq * 8), boff = lds_byte(wc * 32 + fr, fq * 8);
#define PG8_SA(b, h) (((b) * 2 + (h)) * HTB)
#define PG8_SB(b, h) ((4 + (b) * 2 + (h)) * HTB)
#define PG8_STAGE(bufoff, gbase, voff) do { _Pragma("unroll") for (int _i = 0; _i < 2; ++_i) \
        __builtin_amdgcn_global_load_lds((const unsigned*)((const char*)(gbase) + (voff)[_i]), (LAS unsigned*)(lds + (bufoff) + ldsw + _i * 8192), 16, 0, 0); } while (0)
#define PG8_LDA(dst, b, h) do { _Pragma("unroll") for (int m = 0; m < 4; ++m) _Pragma("unroll") for (int k = 0; k < 2; ++k) dst[m][k] = *(const LAS bf16x8*)(lds + PG8_SA(b, h) + aoff + m * 2048 + k * 1024); } while (0)
#define PG8_LDB(dst, b, h) do { _Pragma("unroll") for (int n = 0; n < 2; ++n) _Pragma("unroll") for (int k = 0; k < 2; ++k) dst[n][k] = *(const LAS bf16x8*)(lds + PG8_SB(b, h) + boff + n * 2048 + k * 1024); } while (0)
#define PG8_MMA(ai, bj, At, Bt) do { __builtin_amdgcn_s_setprio(1); _Pragma("unroll") for (int m = 0; m < 4; ++m) _Pragma("unroll") for (int n = 0; n < 2; ++n) _Pragma("unroll") for (int k = 0; k < 2; ++k) \
        acc[ai][bj][m][n] = __builtin_amdgcn_mfma_f32_16x16x32_bf16(Bt[n][k], At[m][k], acc[ai][bj][m][n], 0, 0, 0); __builtin_amdgcn_s_setprio(0); } while (0)
#define PG8_WAIT_V(n) asm volatile("s_waitcnt vmcnt(" #n ")" ::: "memory")
#define PG8_WAIT_L(n) asm volatile("s_waitcnt lgkmcnt(" #n ")" ::: "memory")
#define PG8_BAR __builtin_amdgcn_s_barrier()
#define PG8_SCHED __builtin_amdgcn_sched_barrier(0)
#define PG8_AOFF(dst, u) do { _Pragma("unroll") for (int _h = 0; _h < 2; ++_h) _Pragma("unroll") for (int _i = 0; _i < 2; ++_i) \
        dst[_h][_i] = (unsigned)(((size_t)S.a_row(u, _h * HALF + Rr[_i]) * S.lda + Cc[_i]) * 2u); } while (0)
    Unit cur, nxt; int ui = 0;
    if (!S.next(0, cur)) return;
    f32x4 acc[2][2][4][2];
#pragma unroll
    for (int a = 0; a < 2; ++a)
#pragma unroll
        for (int b = 0; b < 2; ++b)
#pragma unroll
            for (int m = 0; m < 4; ++m)
#pragma unroll
                for (int n = 0; n < 2; ++n) acc[a][b][m][n] = (f32x4){0.f, 0.f, 0.f, 0.f};
    bf16x8 At[4][2], B0[2][2], B1[2][2];
    const char* cA = S.a_ptr(cur); const char* cB = S.b_ptr(cur);
    PG8_AOFF(voffA, cur);
    PG8_STAGE(PG8_SB(0, 0), cB, voffB); PG8_STAGE(PG8_SB(0, 1), cB + hstepB, voffB); PG8_STAGE(PG8_SA(0, 0), cA, voffA[0]); PG8_STAGE(PG8_SA(0, 1), cA, voffA[1]);
    if (wr == 1) PG8_BAR;
    PG8_WAIT_V(2); PG8_BAR;
    PG8_STAGE(PG8_SB(1, 0), cB + kstep, voffB); PG8_STAGE(PG8_SA(1, 0), cA + kstep, voffA[0]); PG8_STAGE(PG8_SB(1, 1), cB + hstepB + kstep, voffB);
    PG8_WAIT_V(6); PG8_BAR;
    for (;;) {
        const bool has_next = S.next(ui + 1, nxt);
        const char* nA = has_next ? S.a_ptr(nxt) : cA; const char* nB = has_next ? S.b_ptr(nxt) : cB;
        if (has_next) { PG8_AOFF(voffN, nxt); } else {
#pragma unroll
            for (int h = 0; h < 2; ++h)
#pragma unroll
                for (int i = 0; i < 2; ++i) voffN[h][i] = voffA[h][i]; }
        for (int t = 0; t < nt; t += 2) {
            const bool last = (t == nt - 2);
            const char* a1 = cA + (size_t)(t + 1) * kstep;
            const char* a2 = last ? nA : cA + (size_t)(t + 2) * kstep; const char* b2 = last ? nB : cB + (size_t)(t + 2) * kstep;
            const char* a3 = a2 + kstep; const char* b3 = b2 + kstep;
            unsigned vo2[2][2];
#pragma unroll
            for (int h = 0; h < 2; ++h)
#pragma unroll
                for (int i = 0; i < 2; ++i) vo2[h][i] = last ? voffN[h][i] : voffA[h][i];
            PG8_LDB(B0, 0, 0); PG8_LDB(B1, 0, 1); PG8_SCHED; PG8_LDA(At, 0, 0); PG8_STAGE(PG8_SA(1, 1), a1, voffA[1]);
            PG8_WAIT_V(8); PG8_WAIT_L(0); PG8_BAR; PG8_MMA(0, 0, At, B0); PG8_MMA(0, 1, At, B1); PG8_BAR; PG8_SCHED;
            PG8_LDA(At, 0, 1); PG8_STAGE(PG8_SB(0, 0), b2, voffB); PG8_STAGE(PG8_SB(0, 1), b2 + hstepB, voffB); PG8_STAGE(PG8_SA(0, 0), a2, vo2[0]);
            PG8_WAIT_V(8); PG8_WAIT_L(0); PG8_BAR; PG8_MMA(1, 0, At, B0); PG8_MMA(1, 1, At, B1); PG8_BAR; PG8_SCHED;
            PG8_LDB(B0, 1, 0); PG8_LDB(B1, 1, 1); PG8_SCHED; PG8_LDA(At, 1, 0); PG8_STAGE(PG8_SA(0, 1), a2, vo2[1]);
            PG8_WAIT_V(8); PG8_WAIT_L(0); PG8_BAR; PG8_MMA(0, 0, At, B0); PG8_MMA(0, 1, At, B1); PG8_BAR; PG8_SCHED;
            PG8_LDA(At, 1, 1); PG8_STAGE(PG8_SB(1, 0), b3, voffB); PG8_STAGE(PG8_SB(1, 1), b3 + hstepB, voffB); PG8_STAGE(PG8_SA(1, 0), a3, vo2[0]);
            PG8_WAIT_V(8); PG8_WAIT_L(0); PG8_BAR; PG8_MMA(1, 0, At, B0); PG8_MMA(1, 1, At, B1); PG8_BAR; PG8_SCHED;
        }
        if constexpr (ALIGN_EPI) { if (wr == 0) PG8_BAR; }
        E(acc, cur, wr, wc, fr, fq);
        if (!has_next) break;
#pragma unroll
        for (int a = 0; a < 2; ++a)
#pragma unroll
            for (int b = 0; b < 2; ++b)
#pragma unroll
                for (int m = 0; m < 4; ++m)
#pragma unroll
                    for (int n = 0; n < 2; ++n) acc[a][b][m][n] = (f32x4){0.f, 0.f, 0.f, 0.f};
        cur = nxt; cA = nA; cB = nB; ++ui;
#pragma unroll
        for (int h = 0; h < 2; ++h)
#pragma unroll
            for (int i = 0; i < 2; ++i) voffA[h][i] = voffN[h][i];
        if constexpr (ALIGN_EPI) { if (wr == 1) PG8_BAR; }
    }
    PG8_WAIT_V(0);
    if constexpr (!ALIGN_EPI) { if (wr == 0) PG8_BAR; }
    PG8_BAR;
#undef PG8_SA
#undef PG8_SB
#undef PG8_STAGE
#undef PG8_LDA
#undef PG8_LDB
#undef PG8_MMA
#undef PG8_WAIT_V
#undef PG8_WAIT_L
#undef PG8_BAR
#undef PG8_SCHED
#undef PG8_AOFF
}
}

#define XB_TMO      128
#define XB_XCNT(j)  (256  + 64 * (j))
#define XB_XSUB(j)  (1280 + 64 * (j))
#define XB_XGEN(j)  (2304 + 64 * (j))
#define XB_TOP      3328
#define XB_TOPGEN   3392
#define XCD_BAR_WORDS 3456
#define XB_SPIN_CAP (1u << 20)
__device__ __forceinline__ unsigned xb_ld(unsigned* p)              { return __hip_atomic_load(p, __ATOMIC_RELAXED, __HIP_MEMORY_SCOPE_AGENT); }
__device__ __forceinline__ unsigned xb_add(unsigned* p, unsigned v) { return __hip_atomic_fetch_add(p, v, __ATOMIC_RELAXED, __HIP_MEMORY_SCOPE_AGENT); }
__device__ __forceinline__ unsigned xb_xcc_id() { return (unsigned)__builtin_amdgcn_s_getreg((3 << 11) | 20) & 0xFu; }
#define XB_SPIN(cond, bar) do { unsigned _sp = 0; while (cond) { __builtin_amdgcn_s_sleep(1); \
    if ((++_sp & 255u) == 0u) { if (xb_ld(&(bar)[XB_TMO])) break; if (_sp > XB_SPIN_CAP) { atomicAdd(&(bar)[XB_TMO], 1u); break; } } } } while (0)
struct XcdBarrier { unsigned* bar; unsigned x; volatile LAS unsigned* st; };
__device__ __forceinline__ XcdBarrier xcd_barrier_post(unsigned* bar, volatile LAS unsigned* st) {
    XcdBarrier b; b.bar = bar; b.x = xb_xcc_id(); b.st = st;
    if (threadIdx.x == 0) (void)xb_add(&bar[XB_XCNT(b.x)], 1u);
    return b;
}
__device__ __forceinline__ void xcd_barrier_complete(unsigned* bar, unsigned x, unsigned& nloc, unsigned& nx) {
    const unsigned G = gridDim.x * gridDim.y * gridDim.z;
    unsigned sum, cnt, mine, sp = 0u;
    for (;;) {
        sum = 0u; cnt = 0u; mine = 0u;
#pragma unroll
        for (unsigned j = 0; j < 16; ++j) { const unsigned c = xb_ld(&bar[XB_XCNT(j)]); sum += c; cnt += (c > 0u) ? 1u : 0u; mine = (j == x) ? c : mine; }
        if (sum == G) break;
        __builtin_amdgcn_s_sleep(1);
        if ((++sp & 255u) == 0u) { if (xb_ld(&bar[XB_TMO])) break; if (sp > XB_SPIN_CAP) { atomicAdd(&bar[XB_TMO], 1u); break; } }
    }
    nloc = mine > 0u ? mine : 1u; nx = cnt > 0u ? cnt : 1u;
}
__device__ __forceinline__ void xcd_barrier(const XcdBarrier& b) {
    asm volatile("s_waitcnt vmcnt(0)" ::: "memory");
    __syncthreads();
    if (threadIdx.x == 0) {
        unsigned* bar = b.bar;
        __builtin_amdgcn_s_waitcnt(0);
        unsigned nloc = b.st[0], nx = b.st[1];
        if (nloc == 0u) { xcd_barrier_complete(bar, b.x, nloc, nx); b.st[0] = nloc; b.st[1] = nx; }
        const unsigned old = xb_add(&bar[XB_XSUB(b.x)], 1u);
        const unsigned gen = old / nloc;
        if (old + 1u == (gen + 1u) * nloc) {
            __builtin_amdgcn_fence(__ATOMIC_RELEASE, "agent");
            asm volatile("s_waitcnt vmcnt(0)" ::: "memory");
            const unsigned og = xb_add(&bar[XB_TOP], 1u);
            const unsigned tg = og / nx;
            if (og + 1u == (tg + 1u) * nx) xb_add(&bar[XB_TOPGEN], 1u);
            else XB_SPIN(xb_ld(&bar[XB_TOPGEN]) == tg, bar);
            __builtin_amdgcn_fence(__ATOMIC_ACQUIRE, "agent");
            xb_add(&bar[XB_XGEN(b.x)], 1u);
            asm volatile("s_waitcnt vmcnt(0)" ::: "memory");
        } else {
            XB_SPIN(xb_ld(&bar[XB_XGEN(b.x)]) == gen, bar);
            __builtin_amdgcn_fence(__ATOMIC_ACQUIRE, "agent");
            asm volatile("s_waitcnt vmcnt(0)" ::: "memory");
        }
    }
    __syncthreads();
}

constexpr int NWAVES = 8, NTHR = 512;
constexpr int RING_BYTES = 131072;
constexpr int LDS_AUX = RING_BYTES;
constexpr int LDS_AUX_BYTES = 12288;
constexpr int MISC_OFF = LDS_AUX + LDS_AUX_BYTES;
constexpr int LDS_BYTES = MISC_OFF + 256;

struct Args {
    const float* in[28]; float* out; unsigned char* ws; int ph_lo, ph_hi;
};
struct Frame {
    LAS unsigned char* lds; volatile LAS unsigned* MISC; unsigned* ctl;
    int tid, lane, wave, vcu, G;
    unsigned char* ws;
};

__device__ __forceinline__ void transpose_item(const float* W, int ldw, int k0, int scol0, bf16* WT, int ldt, int drow0, const float* ks, LAS float* scr, int lane) {
#pragma unroll 8
    for (int i = 0; i < 32; ++i) { const int kk = 2 * i + (lane >> 5); float v = W[(size_t)(k0 + kk) * ldw + scol0 + (lane & 31)]; if (ks) v *= ks[k0 + kk]; scr[kk * 33 + (lane & 31)] = v; }
    asm volatile("s_waitcnt lgkmcnt(0)" ::: "memory");
    const int c = lane & 7;
#pragma unroll
    for (int j = 0; j < 4; ++j) { const int n = (lane >> 3) + 8 * j; const LAS float* s = scr + (8 * c) * 33 + n;
        v4u o; o.x = pk2(s[0 * 33], s[1 * 33]); o.y = pk2(s[2 * 33], s[3 * 33]); o.z = pk2(s[4 * 33], s[5 * 33]); o.w = pk2(s[6 * 33], s[7 * 33]);
        *(v4u*)(WT + (size_t)(drow0 + n) * ldt + k0 + 8 * c) = o; }
    asm volatile("s_waitcnt lgkmcnt(0)" ::: "memory");
}

__device__ __forceinline__ void tconv64(const float* W, int ldw, int k0, int scol0, bf16* WT, int ldt, int drow0, const float* ks, LAS unsigned char* scr, int lane) {
    const int rsub = lane >> 4, c4 = lane & 15;
    f32x4 v[16];
    const float* src = W + (size_t)(k0 + 16 * rsub) * ldw + scol0 + 4 * c4;
#pragma unroll
    for (int i = 0; i < 16; ++i) v[i] = *(const f32x4*)(src + (size_t)i * ldw);
    if (ks) {
#pragma unroll
        for (int q = 0; q < 4; ++q) { const f32x4 s4 = *(const f32x4*)(ks + k0 + 16 * rsub + 4 * q);
            v[4 * q] = v[4 * q] * s4.x; v[4 * q + 1] = v[4 * q + 1] * s4.y; v[4 * q + 2] = v[4 * q + 2] * s4.z; v[4 * q + 3] = v[4 * q + 3] * s4.w; } }
    const int swz = c4 & 7;
#pragma unroll
    for (int j = 0; j < 4; ++j) { const int n = 4 * c4 + j;
        const v4u lo = (v4u){pk2(v[0][j], v[1][j]), pk2(v[2][j], v[3][j]), pk2(v[4][j], v[5][j]), pk2(v[6][j], v[7][j])};
        const v4u hi = (v4u){pk2(v[8][j], v[9][j]), pk2(v[10][j], v[11][j]), pk2(v[12][j], v[13][j]), pk2(v[14][j], v[15][j])};
        *(LAS v4u*)(scr + n * 128 + (((2 * rsub) ^ swz) * 16)) = lo;
        *(LAS v4u*)(scr + n * 128 + (((2 * rsub + 1) ^ swz) * 16)) = hi; }
    asm volatile("s_waitcnt lgkmcnt(0)" ::: "memory");
#pragma unroll
    for (int i = 0; i < 8; ++i) { const int n = 8 * i + (lane >> 3), ch = lane & 7;
        const v4u o = *(const LAS v4u*)(scr + n * 128 + ((ch ^ ((n >> 2) & 7)) * 16));
        *(v4u*)(WT + (size_t)(drow0 + n) * ldt + k0 + 8 * ch) = o; }
    asm volatile("s_waitcnt lgkmcnt(0)" ::: "memory");
}

struct DenseSched {
    static constexpr int NXCD = 8, WGM = 8;
    const bf16* A; const bf16* Bt; int K, lda, ldb, nM, nN, nwg, G, c, reps;
    __device__ void init(const bf16* A_, const bf16* Bt_, int M, int N, int K_, int lda_, int ldb_, int G_, int c_) { A = A_; Bt = Bt_; K = K_; lda = lda_; ldb = ldb_; nM = M / 256; nN = N / 256; nwg = nM * nN; G = G_; c = c_; reps = 1; }
    __device__ __forceinline__ bool next(int i, pg8::Unit& u) const {
        const long Lx = (long)i * G + c; if (Lx >= (long)nwg * reps) return false;
        int wgid = (int)(Lx % nwg); { const int q = nwg / NXCD, r = nwg % NXCD, xcd = wgid % NXCD, off = wgid / NXCD; wgid = (xcd < r ? xcd * (q + 1) : r * (q + 1) + (xcd - r) * q) + off; }
        const int nig = WGM * nN, gid = wgid / nig, fm = gid * WGM, gsz = (nM - fm) < WGM ? (nM - fm) : WGM;
        u.pm = fm + ((wgid % nig) % gsz); u.pn = (wgid % nig) / gsz; u.e = 0; u.rows = 256; u.slot0 = u.pm * 256; u.lidx = i; return true;
    }
    __device__ __forceinline__ const char* a_ptr(const pg8::Unit&) const { return (const char*)A; }
    __device__ __forceinline__ const char* b_ptr(const pg8::Unit& u) const { return (const char*)(Bt + (size_t)u.pn * 256 * ldb); }
    __device__ __forceinline__ int a_row(const pg8::Unit& u, int r) const { return u.pm * 256 + r; }
};

constexpr int MOE_MAXU = 8;
struct MoeSched {
    const bf16* A; const bf16* Bt; int K, lda, ldb, G, c; size_t bstride;
    const LAS int* toff; const LAS int* soff; const LAS int* tokl;
    int nunits, reps; bool gather;
    __device__ __forceinline__ bool next(int i, pg8::Unit& u) const {
        int Lx = i * G + c; if (Lx >= nunits * reps) return false; Lx %= nunits;
        const int mtg = Lx >> 2; u.pn = Lx & 3;
        int e = 0;
#pragma unroll 1
        for (int j = 0; j < NE; ++j) if (toff[j + 1] <= mtg) e = j + 1;
        u.e = e; const int mt = mtg - toff[e]; u.pm = mt; const int ce = soff[e + 1] - soff[e];
        u.rows = min(256, ce - mt * 256); u.slot0 = soff[e] + mt * 256; u.lidx = i; return true;
    }
    __device__ __forceinline__ const char* a_ptr(const pg8::Unit&) const { return (const char*)A; }
    __device__ __forceinline__ const char* b_ptr(const pg8::Unit& u) const { return (const char*)(Bt + (size_t)u.e * bstride + (size_t)u.pn * 256 * ldb); }
    __device__ __forceinline__ int a_row(const pg8::Unit& u, int r) const { return gather ? tokl[u.lidx * 256 + r] : (u.slot0 + r); }
};

struct EpiInProj {
    static constexpr bool PERM = true;
    bf16* qkvo; bf16* ag;
    __device__ __forceinline__ void operator()(const f32x4 (&acc)[2][2][4][2], const pg8::Unit& u, int wr, int wc, int fr, int fq) const {
        const int row0 = u.pm * 256 + wr * 64 + fr; const int colt = u.pn * 256 + wc * 32 + 8 * fq;
#pragma unroll
        for (int ai = 0; ai < 2; ++ai)
#pragma unroll
            for (int m = 0; m < 4; ++m) { const int row = row0 + ai * 128 + m * 16;
#pragma unroll
                for (int bj = 0; bj < 2; ++bj) { const f32x4 v0 = acc[ai][bj][m][0], v1 = acc[ai][bj][m][1];
                    v4u w; w.x = pg8::cvt_pk_bf16(v0[0], v0[1]); w.y = pg8::cvt_pk_bf16(v0[2], v0[3]); w.z = pg8::cvt_pk_bf16(v1[0], v1[1]); w.w = pg8::cvt_pk_bf16(v1[2], v1[3]);
                    const int col = colt + bj * 128;
                    if (u.pn < 8) { *(v4u*)(qkvo + (size_t)(col >> 9) * T * 512 + (size_t)row * 512 + (col & 511)) = w; }
                    else { const int cu = col - 2048, g = cu >> 4, h0 = cu & 15; *(v4u*)(ag + ((size_t)g * NCH + (row >> 5)) * AGK + (row & 31) * 16 + h0) = w; } } }
    }
};
struct EpiResF32 {
    static constexpr bool PERM = false;
    const float* base; float* out;
    __device__ __forceinline__ void operator()(const f32x4 (&acc)[2][2][4][2], const pg8::Unit& u, int wr, int wc, int fr, int fq) const {
        const int row0 = u.pm * 256 + wr * 64 + fr, col0 = u.pn * 256 + wc * 32 + 4 * fq;
#pragma unroll
        for (int ai = 0; ai < 2; ++ai)
#pragma unroll
            for (int m = 0; m < 4; ++m) { const size_t off = (size_t)(row0 + ai * 128 + m * 16) * D + col0;
#pragma unroll
                for (int bj = 0; bj < 2; ++bj)
#pragma unroll
                    for (int n = 0; n < 2; ++n) { const f32x4 bs = *(const f32x4*)(base + off + bj * 128 + n * 16); *(f32x4*)(out + off + bj * 128 + n * 16) = bs + acc[ai][bj][m][n]; }
                asm volatile("" ::: "memory"); }
    }
};
struct EpiGateUp {
    static constexpr bool PERM = true;
    bf16* H; const LAS int* tokl; const float* rs2;
    __device__ __forceinline__ void operator()(const f32x4 (&acc)[2][2][4][2], const pg8::Unit& u, int wr, int wc, int fr, int fq) const {
        const int r0 = wr * 64 + fr; const int col = u.pn * 128 + wc * 32 + 8 * fq;
#pragma unroll
        for (int ai = 0; ai < 2; ++ai)
#pragma unroll
            for (int m = 0; m < 4; ++m) { const int r = r0 + ai * 128 + m * 16;
                const float rs = rs2[tokl[u.lidx * 256 + r]];
                float o[8];
#pragma unroll
                for (int n = 0; n < 2; ++n)
#pragma unroll
                    for (int j = 0; j < 4; ++j) o[4 * n + j] = siluf_(acc[ai][0][m][n][j] * rs) * (acc[ai][1][m][n][j] * rs);
                v4u w; w.x = pg8::cvt_pk_bf16(o[0], o[1]); w.y = pg8::cvt_pk_bf16(o[2], o[3]); w.z = pg8::cvt_pk_bf16(o[4], o[5]); w.w = pg8::cvt_pk_bf16(o[6], o[7]);
                if (r < u.rows) *(v4u*)(H + (size_t)(u.slot0 + r) * DE + col) = w; }
    }
};
struct EpiDown {
    static constexpr bool PERM = true;
    bf16* Y;
    __device__ __forceinline__ void operator()(const f32x4 (&acc)[2][2][4][2], const pg8::Unit& u, int wr, int wc, int fr, int fq) const {
        const int r0 = wr * 64 + fr; const int col = u.pn * 256 + wc * 32 + 8 * fq;
#pragma unroll
        for (int ai = 0; ai < 2; ++ai)
#pragma unroll
            for (int m = 0; m < 4; ++m) { const int r = r0 + ai * 128 + m * 16;
#pragma unroll
                for (int bj = 0; bj < 2; ++bj) { const f32x4 v0 = acc[ai][bj][m][0], v1 = acc[ai][bj][m][1];
                    v4u w; w.x = pg8::cvt_pk_bf16(v0[0], v0[1]); w.y = pg8::cvt_pk_bf16(v0[2], v0[3]); w.z = pg8::cvt_pk_bf16(v1[0], v1[1]); w.w = pg8::cvt_pk_bf16(v1[2], v1[3]);
                    if (r < u.rows) *(v4u*)(Y + (size_t)(u.slot0 + r) * D + col + bj * 128) = w; } }
    }
};


typedef short s16x4 __attribute__((ext_vector_type(4)));
typedef short v4i16_t __attribute__((ext_vector_type(4)));
typedef float f32x16 __attribute__((ext_vector_type(16)));
__device__ __forceinline__ unsigned off_b(unsigned row, unsigned ch) { return 256u * row + 16u * (ch ^ (((row & 3) << 2) | ((row >> 2) & 3))); }
__device__ __forceinline__ s16x4 vtr(const LAS unsigned char* p) { return __builtin_bit_cast(s16x4, __builtin_amdgcn_ds_read_tr16_b64_v4i16((LAS v4i16_t*)p)); }
__device__ __forceinline__ unsigned tr_addr(unsigned row_base, unsigned c, unsigned lane) { const unsigned q = (lane & 15) >> 2, p = lane & 3; return off_b(row_base + q, 2 * c + (p >> 1)) + 8 * (p & 1); }
__device__ __forceinline__ bf16x8 cat4(s16x4 lo, s16x4 hi) { bf16x8 r; r[0] = lo[0]; r[1] = lo[1]; r[2] = lo[2]; r[3] = lo[3]; r[4] = hi[0]; r[5] = hi[1]; r[6] = hi[2]; r[7] = hi[3]; return r; }
__device__ __forceinline__ float wave_max(float v) {
#pragma unroll
    for (int o = 1; o < 64; o <<= 1) v = fmaxf(v, __shfl_xor(v, o));
    return v;
}
__device__ __forceinline__ void chunk_gates(const float* gates, int t0, int h, int lane, float& bcs, float& g) {
    const float li = gates[(size_t)(t0 + lane) * 8 + h], lf = gates[(size_t)(t0 + lane) * 8 + 4 + h];
    bcs = lf;
#pragma unroll
    for (int o = 1; o < 64; o <<= 1) { const float tv = __shfl_up(bcs, o); if (lane >= o) bcs += tv; }
    g = li - bcs;
}
__device__ __forceinline__ void conv4x8(const bf16* src, int tl0, const float* cw, const float* cb, float scale, v4u (&outp)[4]) {
    v4u raw[7];
#pragma unroll
    for (int i = 0; i < 7; ++i) { raw[i] = (v4u){0u, 0u, 0u, 0u}; if (tl0 - 3 + i >= 0) raw[i] = *(const v4u*)(src + (ptrdiff_t)(i - 3) * 512); }
    float w[4][8], bb[8];
#pragma unroll
    for (int j = 0; j < 4; ++j) { const f32x4 a = *(const f32x4*)(cw + j * 1024), b = *(const f32x4*)(cw + j * 1024 + 4); w[j][0] = a.x; w[j][1] = a.y; w[j][2] = a.z; w[j][3] = a.w; w[j][4] = b.x; w[j][5] = b.y; w[j][6] = b.z; w[j][7] = b.w; }
    { const f32x4 a = *(const f32x4*)cb, b = *(const f32x4*)(cb + 4); bb[0] = a.x; bb[1] = a.y; bb[2] = a.z; bb[3] = a.w; bb[4] = b.x; bb[5] = b.y; bb[6] = b.z; bb[7] = b.w; }
#pragma unroll
    for (int r = 0; r < 4; ++r) {
        float o[8];
#pragma unroll
        for (int e = 0; e < 8; ++e) { float a = bb[e];
#pragma unroll
            for (int j = 0; j < 4; ++j) { const unsigned d = raw[r + j][e >> 1]; a += w[j][e] * bf2f((e & 1) ? (d >> 16) : (d & 0xffffu)); }
            o[e] = siluf_(a) * scale; }
        outp[r] = (v4u){pk2(o[0], o[1]), pk2(o[2], o[3]), pk2(o[4], o[5]), pk2(o[6], o[7])};
    }
}

__device__ __forceinline__ void mlstm_a_pair(const Frame& F, int pair, const bf16* qkvo, const float* gates, const float* conv_w, const float* conv_b, bf16* dC, float* dn, float* msc) {
    const int hb = F.wave >> 2, w4 = F.wave & 3, tid4 = F.tid & 255, lane = F.lane, g4 = lane >> 4;
    const int unit = 2 * pair + hb, bh = unit >> 7, c = unit & 127, b = bh >> 2, h = bh & 3, t0 = b * L + c * 64;
    LAS unsigned char* Kimg = F.lds + hb * 65536; LAS unsigned char* Vimg = Kimg + 16384;
    float bcs, g; chunk_gates(gates, t0, h, lane, bcs, g);
    const float gmax = wave_max(g), wgt = __expf(g - gmax), bl = __shfl(bcs, 63);
    if (w4 == 0 && lane == 0) { msc[unit * 4 + 0] = bl + gmax; msc[unit * 4 + 1] = bl; }
    const int d8 = tid4 & 15, rg = tid4 >> 4;
    { v4u kc[4]; conv4x8(qkvo + (size_t)1 * T * 512 + (size_t)(t0 + 4 * rg) * 512 + h * 128 + 8 * d8, c * 64 + 4 * rg, conv_w + 512 + h * 128 + 8 * d8, conv_b + 512 + h * 128 + 8 * d8, 0.08838834764831845f, kc);
#pragma unroll
      for (int r = 0; r < 4; ++r) { const float ws = __shfl(wgt, 4 * rg + r);
          v4u o;
#pragma unroll
          for (int q = 0; q < 4; ++q) o[q] = pk2(bf2f(kc[r][q] & 0xffffu) * ws, bf2f(kc[r][q] >> 16) * ws);
          *(LAS v4u*)(Kimg + off_b(4 * rg + r, d8)) = o; }
#pragma unroll
      for (int r = 0; r < 4; ++r) *(LAS v4u*)(Vimg + off_b(4 * rg + r, d8)) = *(const v4u*)(qkvo + (size_t)2 * T * 512 + (size_t)(t0 + 4 * rg + r) * 512 + h * 128 + 8 * d8); }
    __syncthreads();
    f32x4 acc[2][8], accn[2];
#pragma unroll
    for (int a = 0; a < 2; ++a) { accn[a] = (f32x4){0.f, 0.f, 0.f, 0.f};
#pragma unroll
        for (int n = 0; n < 8; ++n) acc[a][n] = (f32x4){0.f, 0.f, 0.f, 0.f}; }
    bf16x8 ones; { const short o = ((lane & 15) == 0) ? (short)0x3F80 : (short)0;
#pragma unroll
        for (int j = 0; j < 8; ++j) ones[j] = o; }
#pragma unroll
    for (int ks = 0; ks < 2; ++ks) {
        bf16x8 a[2];
#pragma unroll
        for (int m2 = 0; m2 < 2; ++m2) a[m2] = cat4(vtr(Kimg + tr_addr(32 * ks + 8 * g4, 2 * w4 + m2, lane)), vtr(Kimg + tr_addr(32 * ks + 8 * g4 + 4, 2 * w4 + m2, lane)));
#pragma unroll
        for (int n = 0; n < 8; ++n) { const bf16x8 bv = cat4(vtr(Vimg + tr_addr(32 * ks + 8 * g4, n, lane)), vtr(Vimg + tr_addr(32 * ks + 8 * g4 + 4, n, lane)));
#pragma unroll
            for (int m2 = 0; m2 < 2; ++m2) acc[m2][n] = __builtin_amdgcn_mfma_f32_16x16x32_bf16(a[m2], bv, acc[m2][n], 0, 0, 0); }
#pragma unroll
        for (int m2 = 0; m2 < 2; ++m2) accn[m2] = __builtin_amdgcn_mfma_f32_16x16x32_bf16(a[m2], ones, accn[m2], 0, 0, 0);
    }
#pragma unroll
    for (int m2 = 0; m2 < 2; ++m2) { const int k0 = 16 * (2 * w4 + m2) + 4 * g4;
#pragma unroll
        for (int n = 0; n < 8; ++n) { const int v = 16 * n + (lane & 15); *(v2u*)(dC + ((size_t)unit * 128 + v) * 128 + k0) = (v2u){pk2(acc[m2][n][0], acc[m2][n][1]), pk2(acc[m2][n][2], acc[m2][n][3])}; }
        if ((lane & 15) == 0) *(f32x4*)(dn + (size_t)unit * 128 + k0) = accn[m2]; }
    __syncthreads();
}

__device__ __forceinline__ void mlstm_b(const Frame& F, bf16* dC, float* dn, float* msc) {
    LAS float* sa = (LAS float*)(F.lds); LAS float* sb = sa + 128; LAS float* fd = sa + 256; LAS float* iw = sa + 384; LAS float* mm = sa + 512;
    for (int e0 = F.vcu * NTHR; e0 < 8 * 16384; e0 += F.G * NTHR) {
        const int e = e0 + F.tid, bh = e0 >> 14, idx = e & 16383;
        if (F.tid < 128) { sa[F.tid] = msc[(bh * 128 + F.tid) * 4 + 0]; sb[F.tid] = msc[(bh * 128 + F.tid) * 4 + 1]; }
        __syncthreads();
        if (F.tid == 0) { float m = 0.f; for (int c = 0; c < 128; ++c) { const float mn = fmaxf(sb[c] + m, sa[c]); fd[c] = __expf(sb[c] + m - mn); iw[c] = __expf(sa[c] - mn); mm[c] = m; m = mn; } }
        __syncthreads();
        bf16* p = dC + (size_t)bh * 128 * 16384 + idx;
        float C = 0.f;
#pragma unroll 8
        for (int c = 0; c < 128; ++c) { const float d = bf2f(p[(size_t)c * 16384]); p[(size_t)c * 16384] = (bf16)f2bf(C); C = fd[c] * C + iw[c] * d; }
        if (idx < 128) { float* q = dn + (size_t)bh * 128 * 128 + idx; float nn = 0.f;
#pragma unroll 8
            for (int c = 0; c < 128; ++c) { const float d = q[c * 128]; q[c * 128] = nn; nn = fd[c] * nn + iw[c] * d; } }
        if (idx == 0) for (int c = 0; c < 128; ++c) msc[(bh * 128 + c) * 4 + 2] = mm[c];
        __syncthreads();
    }
}

__device__ __forceinline__ void mlstm_c_pair(const Frame& F, int pair, const bf16* qkvo, const float* gates, const float* conv_w, const float* conv_b, const bf16* Cst, const float* nst, const float* msc, const float* ng, bf16* merged) {
    const int hb = F.wave >> 2, w4 = F.wave & 3, tid4 = F.tid & 255, lane = F.lane, g4 = lane >> 4, l15 = lane & 15;
    const int unit = 2 * pair + hb, bh = unit >> 7, c = unit & 127, b = bh >> 2, h = bh & 3, t0 = b * L + c * 64;
    LAS unsigned char* Kimg = F.lds + hb * 65536; LAS unsigned char* Vimg = Kimg + 16384; LAS unsigned char* Cimg = Kimg + 32768; LAS unsigned char* Qimg = Cimg;
    LAS float* gl = (LAS float*)(F.lds + LDS_AUX + hb * 4096); LAS float* bcl = gl + 64; LAS float* nl = gl + 128;
    float bcs, g; chunk_gates(gates, t0, h, lane, bcs, g);
    if (w4 == 0) { gl[lane] = g; bcl[lane] = bcs; }
    const float mc = msc[unit * 4 + 2];
    const int d8 = tid4 & 15, rg = tid4 >> 4;
    { v4u kc[4]; conv4x8(qkvo + (size_t)1 * T * 512 + (size_t)(t0 + 4 * rg) * 512 + h * 128 + 8 * d8, c * 64 + 4 * rg, conv_w + 512 + h * 128 + 8 * d8, conv_b + 512 + h * 128 + 8 * d8, 0.08838834764831845f, kc);
#pragma unroll
      for (int r = 0; r < 4; ++r) *(LAS v4u*)(Kimg + off_b(4 * rg + r, d8)) = kc[r]; }
    { v4u qc[4]; conv4x8(qkvo + (size_t)(t0 + 4 * rg) * 512 + h * 128 + 8 * d8, c * 64 + 4 * rg, conv_w + h * 128 + 8 * d8, conv_b + h * 128 + 8 * d8, 1.0f, qc);
#pragma unroll
      for (int r = 0; r < 4; ++r) *(LAS v4u*)(Qimg + off_b(4 * rg + r, d8)) = qc[r]; }
#pragma unroll
    for (int r = 0; r < 4; ++r) *(LAS v4u*)(Vimg + off_b(4 * rg + r, d8)) = *(const v4u*)(qkvo + (size_t)2 * T * 512 + (size_t)(t0 + 4 * rg + r) * 512 + h * 128 + 8 * d8);
    if (tid4 < 128) nl[tid4] = nst[(size_t)unit * 128 + tid4];
    v4u creg[8];
#pragma unroll
    for (int i = 0; i < 8; ++i) creg[i] = *(const v4u*)(Cst + (size_t)unit * 16384 + (size_t)(tid4 + 256 * i) * 8);
    __syncthreads();
    const int jl = 16 * w4 + l15;
    bf16x8 qf[4];
#pragma unroll
    for (int kk = 0; kk < 4; ++kk) qf[kk] = *(const LAS bf16x8*)(Qimg + off_b(jl, 4 * kk + g4));
    float M = mc;
    for (int s = 0; s < 64; ++s) { const float gs = gl[s]; M = (s <= jl) ? fmaxf(M, gs) : M; }
    const float winter = __expf(mc - M);
    v2u sb[4];
#pragma unroll
    for (int st = 0; st < 4; ++st) {
        f32x4 a4 = (f32x4){0.f, 0.f, 0.f, 0.f};
#pragma unroll
        for (int kk = 0; kk < 4; ++kk) { const bf16x8 ka = *(const LAS bf16x8*)(Kimg + off_b(16 * st + l15, 4 * kk + g4)); a4 = __builtin_amdgcn_mfma_f32_16x16x32_bf16(ka, qf[kk], a4, 0, 0, 0); }
        const f32x4 gs = *(const LAS f32x4*)(gl + 16 * st + 4 * g4);
        float vv[4];
#pragma unroll
        for (int r = 0; r < 4; ++r) { const int s = 16 * st + 4 * g4 + r; vv[r] = (s <= jl) ? a4[r] * __expf(gs[r] - M) : 0.f; }
        sb[st] = (v2u){pk2(vv[0], vv[1]), pk2(vv[2], vv[3])};
    }
    __syncthreads();
#pragma unroll
    for (int i = 0; i < 8; ++i) { const int q = tid4 + 256 * i; *(LAS v4u*)(Cimg + off_b(q >> 4, q & 15)) = creg[i]; }
    __syncthreads();
    f32x4 ai[9], ae[9];
#pragma unroll
    for (int vt = 0; vt < 9; ++vt) { ai[vt] = (f32x4){0.f, 0.f, 0.f, 0.f}; ae[vt] = (f32x4){0.f, 0.f, 0.f, 0.f}; }
    bf16x8 ones; { const short o = (l15 == 0) ? (short)0x3F80 : (short)0;
#pragma unroll
        for (int j = 0; j < 8; ++j) ones[j] = o; }
#pragma unroll
    for (int ks = 0; ks < 2; ++ks) {
        bf16x8 bs; { const v4u t4 = (v4u){sb[2 * ks].x, sb[2 * ks].y, sb[2 * ks + 1].x, sb[2 * ks + 1].y}; bs = __builtin_bit_cast(bf16x8, t4); }
#pragma unroll
        for (int vt = 0; vt < 8; ++vt) { const bf16x8 va = cat4(vtr(Vimg + tr_addr(32 * ks + 4 * g4, vt, lane)), vtr(Vimg + tr_addr(32 * ks + 16 + 4 * g4, vt, lane)));
            ai[vt] = __builtin_amdgcn_mfma_f32_16x16x32_bf16(va, bs, ai[vt], 0, 0, 0); }
        ai[8] = __builtin_amdgcn_mfma_f32_16x16x32_bf16(ones, bs, ai[8], 0, 0, 0);
    }
#pragma unroll
    for (int kk = 0; kk < 4; ++kk) {
#pragma unroll
        for (int vt = 0; vt < 8; ++vt) { const bf16x8 ca = *(const LAS bf16x8*)(Cimg + off_b(16 * vt + l15, 4 * kk + g4)); ae[vt] = __builtin_amdgcn_mfma_f32_16x16x32_bf16(ca, qf[kk], ae[vt], 0, 0, 0); }
        bf16x8 na; { const f32x4 n0 = *(const LAS f32x4*)(nl + 32 * kk + 8 * g4), n1 = *(const LAS f32x4*)(nl + 32 * kk + 8 * g4 + 4);
            const v4u t4 = (l15 == 0) ? (v4u){pk2(n0.x, n0.y), pk2(n0.z, n0.w), pk2(n1.x, n1.y), pk2(n1.z, n1.w)} : (v4u){0u, 0u, 0u, 0u}; na = __builtin_bit_cast(bf16x8, t4); }
        ae[8] = __builtin_amdgcn_mfma_f32_16x16x32_bf16(na, qf[kk], ae[8], 0, 0, 0);
    }
    float den = ai[8][0] + winter * ae[8][0];
    den = __shfl(den, l15);
    const float mrow = bcl[jl] + M;
    const float inv = 1.f / fmaxf(fabsf(den), __expf(-mrow));
    float hv[8][4]; float ss = 0.f;
#pragma unroll
    for (int vt = 0; vt < 8; ++vt)
#pragma unroll
        for (int r = 0; r < 4; ++r) { const float x = (ai[vt][r] + winter * ae[vt][r]) * inv; hv[vt][r] = x; ss += x * x; }
    ss += __shfl_xor(ss, 16); ss += __shfl_xor(ss, 32);
    const float rs = rsqrtf(ss * (1.f / 128.f) + EPS);
    const size_t tok = (size_t)(t0 + jl);
#pragma unroll
    for (int vt = 0; vt < 8; ++vt) { const int col = h * 128 + 16 * vt + 4 * g4;
        const v2u ov = *(const v2u*)(qkvo + (size_t)3 * T * 512 + tok * 512 + col); const f32x4 gg = *(const f32x4*)(ng + col);
        const float o0 = sigmoidf_(bf2f(ov.x & 0xffffu)) * (hv[vt][0] * rs * gg.x), o1 = sigmoidf_(bf2f(ov.x >> 16)) * (hv[vt][1] * rs * gg.y);
        const float o2 = sigmoidf_(bf2f(ov.y & 0xffffu)) * (hv[vt][2] * rs * gg.z), o3 = sigmoidf_(bf2f(ov.y >> 16)) * (hv[vt][3] * rs * gg.w);
        *(v2u*)(merged + tok * D + col) = (v2u){pk2(o0, o1), pk2(o2, o3)}; }
    __syncthreads();
}

__device__ __forceinline__ void s5_gen(const Frame& F, int g, const float* lam_re, const float* lam_im, const float* log_dt, const float* b_re, const float* b_im, const float* c_re, const float* c_im, const float* dsk, bf16* TQ, bf16* PG, float* a32) {
    LAS float* apr = (LAS float*)F.lds; LAS float* api = apr + 2148; LAS float* bbr = api + 2148;     LAS float* bbi = bbr + 1024; LAS float* cre = bbi + 1024; LAS float* cim = cre + 1024; LAS float* ktab = cim + 1024;
    const int tid = F.tid;
    if (tid < 64) { const int n = tid, gi = g * SN + n;
        const float lr = fminf(lam_re[gi], -1e-4f), li = lam_im[gi], dt = expf(log_dt[g]);
        const float mag = expf(lr * dt); float sn, cs; sincosf(li * dt, &sn, &cs); const float ar = mag * cs, ai = mag * sn;
        float pr = 1.f, pi = 0.f; apr[n] = 1.f; api[n] = 0.f;
        for (int p = 1; p <= 32; ++p) { const float tr = pr * ar - pi * ai, ti = pr * ai + pi * ar; pr = tr; pi = ti; apr[p * 65 + n] = pr; api[p * 65 + n] = pi; }
        const float den = lr * lr + li * li;
        const float cr = ((ar - 1.f) * lr + ai * li) / den, ci = (ai * lr - (ar - 1.f) * li) / den;
        for (int hh = 0; hh < 16; ++hh) { const float br = b_re[gi * 16 + hh], bi = b_im[gi * 16 + hh]; bbr[n * 16 + hh] = cr * br - ci * bi; bbi[n * 16 + hh] = cr * bi + ci * br; }
        a32[gi * 2] = pr; a32[gi * 2 + 1] = pi; }
    for (int i = tid; i < 1024; i += NTHR) { const int hh = i >> 6, n = i & 63; cre[n * 16 + hh] = c_re[g * 1024 + i]; cim[n * 16 + hh] = c_im[g * 1024 + i]; }
    __syncthreads();
    if (MK_PROBE_A >= 0 && blockIdx.x == 0 && F.tid == 0) F.MISC[16 + 18] = (unsigned)__builtin_amdgcn_s_memrealtime();
    { const int tau = tid >> 4, hh = tid & 15; float acc[16];
#pragma unroll
      for (int q = 0; q < 16; ++q) acc[q] = 0.f;
      for (int n = 0; n < 64; ++n) { const float c_r = cre[n * 16 + hh], c_i = cim[n * 16 + hh], p_r = apr[tau * 65 + n], p_i = api[tau * 65 + n];
          const float xr = c_r * p_r - c_i * p_i, xi = c_r * p_i + c_i * p_r;
#pragma unroll
          for (int q4 = 0; q4 < 4; ++q4) { const f32x4 br = *(const LAS f32x4*)(bbr + n * 16 + 4 * q4), bi = *(const LAS f32x4*)(bbi + n * 16 + 4 * q4);
              acc[4 * q4] += xr * br.x - xi * bi.x; acc[4 * q4 + 1] += xr * br.y - xi * bi.y; acc[4 * q4 + 2] += xr * br.z - xi * bi.z; acc[4 * q4 + 3] += xr * br.w - xi * bi.w; } }
      if (tau == 0) acc[hh] += dsk[g * 16 + hh];
#pragma unroll
      for (int q4 = 0; q4 < 4; ++q4) *(LAS f32x4*)(ktab + tau * 264 + hh * 16 + 4 * q4) = (f32x4){acc[4 * q4], acc[4 * q4 + 1], acc[4 * q4 + 2], acc[4 * q4 + 3]}; }
    __syncthreads();
    if (MK_PROBE_A >= 0 && blockIdx.x == 0 && F.tid == 0) F.MISC[16 + 19] = (unsigned)__builtin_amdgcn_s_memrealtime();
    bf16* tq = TQ + (size_t)g * 512 * AGK; bf16* pg = PG + (size_t)g * 128 * 512;
    for (int row = tid / 80, cch = tid % 80; row < 512; cch += 32, row += 6) { if (cch >= 80) { cch -= 80; ++row; if (row >= 512) break; } const int k0 = cch * 8, j = row >> 4, hh = row & 15; float o[8];
        if (k0 < 512) { const int ii = k0 >> 4, hp0 = k0 & 15, tau = j - ii;
            if (tau >= 0) { const f32x4 t0 = *(const LAS f32x4*)(ktab + tau * 264 + hh * 16 + hp0), t1 = *(const LAS f32x4*)(ktab + tau * 264 + hh * 16 + hp0 + 4);
                o[0] = t0.x; o[1] = t0.y; o[2] = t0.z; o[3] = t0.w; o[4] = t1.x; o[5] = t1.y; o[6] = t1.z; o[7] = t1.w; }
            else {
#pragma unroll
                for (int q = 0; q < 8; ++q) o[q] = 0.f; } }
        else { const int im = (k0 >= 576), n0 = (k0 - 512) & 63;
#pragma unroll
            for (int q = 0; q < 8; ++q) { const int n = n0 + q; const float pr = apr[(j + 1) * 65 + n], pi = api[(j + 1) * 65 + n], cr = cre[n * 16 + hh], ci = cim[n * 16 + hh];
                o[q] = im ? -(cr * pi + ci * pr) : (cr * pr - ci * pi); } }
        *(v4u*)(tq + (size_t)row * AGK + k0) = (v4u){pk2(o[0], o[1]), pk2(o[2], o[3]), pk2(o[4], o[5]), pk2(o[6], o[7])}; }
    if (MK_PROBE_A >= 0 && blockIdx.x == 0 && F.tid == 0) F.MISC[16 + 20] = (unsigned)__builtin_amdgcn_s_memrealtime();
    for (int i = tid; i < 128 * 64; i += NTHR) { const int row = i >> 6, k0 = (i & 63) * 8, im = row >> 6, n = row & 63, ii = k0 >> 4, hp0 = k0 & 15; float o[8];
        const float pr = apr[(31 - ii) * 65 + n], pi = api[(31 - ii) * 65 + n];
#pragma unroll
        for (int q = 0; q < 8; ++q) { const float br = bbr[n * 16 + hp0 + q], bi = bbi[n * 16 + hp0 + q]; o[q] = im ? (pr * bi + pi * br) : (pr * br - pi * bi); }
        *(v4u*)(pg + (size_t)row * 512 + k0) = (v4u){pk2(o[0], o[1]), pk2(o[2], o[3]), pk2(o[4], o[5]), pk2(o[6], o[7])}; }
    __syncthreads();
    if (MK_PROBE_A >= 0 && blockIdx.x == 0 && F.tid == 0) F.MISC[16 + 21] = (unsigned)__builtin_amdgcn_s_memrealtime();
}

__device__ __forceinline__ void s5_scan(const Frame& F, int bg, const float* E, const float* a32, bf16* ag) {
    const int b = bg >> 5, g = bg & 31, n = F.lane, w = F.wave;
    LAS float* ex = (LAS float*)F.lds;
    const float ar = a32[(g * 64 + n) * 2], ai = a32[(g * 64 + n) * 2 + 1];
    const size_t ch0 = (size_t)g * NCH + b * 256 + w * 32;
    float er[32], ei[32];
#pragma unroll
    for (int c = 0; c < 32; ++c) { er[c] = E[(ch0 + c) * 128 + n]; ei[c] = E[(ch0 + c) * 128 + 64 + n]; }
    float sr = 0.f, si = 0.f;
#pragma unroll
    for (int c = 0; c < 32; ++c) { const float nr = ar * sr - ai * si + er[c], ni = ar * si + ai * sr + ei[c]; sr = nr; si = ni; }
    ex[(w * 64 + n) * 2] = sr; ex[(w * 64 + n) * 2 + 1] = si;
    float pr = ar, pi = ai;
#pragma unroll
    for (int q = 0; q < 5; ++q) { const float t = pr * pr - pi * pi; pi = 2.f * pr * pi; pr = t; }
    __syncthreads();
    sr = 0.f; si = 0.f;
    for (int ww = 0; ww < w; ++ww) { const float xr = ex[(ww * 64 + n) * 2], xi = ex[(ww * 64 + n) * 2 + 1]; const float nr = pr * sr - pi * si + xr, ni = pr * si + pi * sr + xi; sr = nr; si = ni; }
#pragma unroll
    for (int c = 0; c < 32; ++c) { bf16* row = ag + (ch0 + c) * AGK + 512; row[n] = (bf16)f2bf(sr); row[64 + n] = (bf16)f2bf(si);
        const float nr = ar * sr - ai * si + er[c], ni = ar * si + ai * sr + ei[c]; sr = nr; si = ni; }
    __syncthreads();
}

__device__ __forceinline__ void s5_post(const Frame& F, int gw, int NGW, const bf16* y5, const float* glu_w, const float* glu_b, bf16* merged) {
    const int lane = F.lane, l31 = lane & 31, half = lane >> 5;
    for (int g = gw & 31; g < 32; g += 32) {
        bf16x8 af; { float a[8];
#pragma unroll
            for (int j = 0; j < 8; ++j) a[j] = glu_w[(size_t)(g * 16 + 8 * half + j) * 32 + l31];
            const v4u t4 = (v4u){pk2(a[0], a[1]), pk2(a[2], a[3]), pk2(a[4], a[5]), pk2(a[6], a[7])}; af = __builtin_bit_cast(bf16x8, t4); }
        f32x16 bias;
#pragma unroll
        for (int r = 0; r < 16; ++r) bias[r] = glu_b[g * 32 + (r & 3) + 8 * (r >> 2) + 4 * half];
        for (int tb = gw >> 5; tb < T / 32; tb += NGW >> 5) {
            const size_t tok = (size_t)tb * 32 + l31;
            const v4u yv = *(const v4u*)(y5 + tok * 512 + g * 16 + 8 * half);
            float y[8];
#pragma unroll
            for (int q = 0; q < 4; ++q) { y[2 * q] = gelu_tanh(bf2f(yv[q] & 0xffffu)); y[2 * q + 1] = gelu_tanh(bf2f(yv[q] >> 16)); }
            const v4u t4 = (v4u){pk2(y[0], y[1]), pk2(y[2], y[3]), pk2(y[4], y[5]), pk2(y[6], y[7])};
            const f32x16 z = __builtin_amdgcn_mfma_f32_32x32x16_bf16(af, __builtin_bit_cast(bf16x8, t4), bias, 0, 0, 0);
            float o[8];
#pragma unroll
            for (int r = 0; r < 8; ++r) o[r] = z[r] * sigmoidf_(z[r + 8]);
            bf16* dst = merged + tok * D + 512 + g * 16 + 4 * half;
            *(v2u*)dst = (v2u){pk2(o[0], o[1]), pk2(o[2], o[3])};
            *(v2u*)(dst + 8) = (v2u){pk2(o[4], o[5]), pk2(o[6], o[7])};
        }
    }
}

struct S5ESched {
    const bf16* AG; const bf16* PG; int K, lda, ldb, G, c, reps;
    __device__ __forceinline__ bool next(int i, pg8::Unit& u) const { int Lx = i * G + c; if (Lx >= 64 * reps) return false; Lx &= 63; u.e = Lx >> 1; u.pm = Lx & 1; u.pn = 0; u.rows = 256; u.slot0 = 0; u.lidx = i; return true; }
    __device__ __forceinline__ const char* a_ptr(const pg8::Unit& u) const { return (const char*)(AG + (size_t)u.e * NCH * AGK); }
    __device__ __forceinline__ const char* b_ptr(const pg8::Unit& u) const { return (const char*)(PG + (size_t)u.e * 128 * 512); }
    __device__ __forceinline__ int a_row(const pg8::Unit& u, int r) const { return u.pm * 256 + r; }
};
struct EpiS5E {
    static constexpr bool PERM = false;
    float* E;
    __device__ __forceinline__ void operator()(const f32x4 (&acc)[2][2][4][2], const pg8::Unit& u, int wr, int wc, int fr, int fq) const {
#pragma unroll
        for (int ai = 0; ai < 2; ++ai)
#pragma unroll
            for (int m = 0; m < 4; ++m) { const int chunk = u.pm * 256 + ai * 128 + wr * 64 + m * 16 + fr;
#pragma unroll
                for (int n = 0; n < 2; ++n) *(f32x4*)(E + ((size_t)u.e * NCH + chunk) * 128 + wc * 32 + 16 * n + 4 * fq) = acc[ai][0][m][n]; }
    }
};
struct S5YSched {
    const bf16* AG; const bf16* TQ; int K, lda, ldb, G, c, reps;
    __device__ __forceinline__ bool next(int i, pg8::Unit& u) const { int Lx = i * G + c; if (Lx >= 128 * reps) return false; Lx &= 127; u.e = Lx >> 2; u.pm = (Lx >> 1) & 1; u.pn = Lx & 1; u.rows = 256; u.slot0 = 0; u.lidx = i; return true; }
    __device__ __forceinline__ const char* a_ptr(const pg8::Unit& u) const { return (const char*)(AG + (size_t)u.e * NCH * AGK); }
    __device__ __forceinline__ const char* b_ptr(const pg8::Unit& u) const { return (const char*)(TQ + (size_t)u.e * 512 * AGK + (size_t)u.pn * 256 * AGK); }
    __device__ __forceinline__ int a_row(const pg8::Unit& u, int r) const { return u.pm * 256 + r; }
};
struct EpiS5Y {
    static constexpr bool PERM = true;
    bf16* y5;
    __device__ __forceinline__ void operator()(const f32x4 (&acc)[2][2][4][2], const pg8::Unit& u, int wr, int wc, int fr, int fq) const {
#pragma unroll
        for (int ai = 0; ai < 2; ++ai)
#pragma unroll
            for (int m = 0; m < 4; ++m) { const int chunk = u.pm * 256 + ai * 128 + wr * 64 + m * 16 + fr;
#pragma unroll
                for (int bj = 0; bj < 2; ++bj) { const f32x4 v0 = acc[ai][bj][m][0], v1 = acc[ai][bj][m][1];
                    v4u w; w.x = pg8::cvt_pk_bf16(v0[0], v0[1]); w.y = pg8::cvt_pk_bf16(v0[2], v0[3]); w.z = pg8::cvt_pk_bf16(v1[0], v1[1]); w.w = pg8::cvt_pk_bf16(v1[2], v1[3]);
                    const int np = u.pn * 256 + bj * 128 + wc * 32 + 8 * fq, j = np >> 4, h0 = np & 15;
                    *(v4u*)(y5 + ((size_t)chunk * 32 + j) * 512 + u.e * 16 + h0) = w; } }
    }
};

__global__ void __launch_bounds__(NTHR, 2) mk_fwd(Args args) {
    extern __shared__ __attribute__((aligned(16))) unsigned char lds_raw[];
    Frame F;
    F.lds = (LAS unsigned char*)lds_raw; F.MISC = (volatile LAS unsigned*)(F.lds + MISC_OFF);
    F.tid = threadIdx.x; F.lane = F.tid & 63; F.wave = __builtin_amdgcn_readfirstlane(F.tid >> 6);
    F.G = gridDim.x; { const int bx = blockIdx.x; F.vcu = (F.G % 8 == 0) ? (bx % 8) * (F.G / 8) + bx / 8 : bx; }
    F.ws = args.ws; F.ctl = (unsigned*)(args.ws + WS_CTL);
    unsigned char* ws = args.ws;
    const int lo = args.ph_lo, hi = args.ph_hi;
    for (int u = F.tid; u < 64; u += NTHR) ((LAS unsigned*)(F.lds + MISC_OFF))[u] = 0u;
    __syncthreads();
    XcdBarrier bar = xcd_barrier_post(F.ctl + CW_BAR, F.MISC + 8);
#define IN(k) (lo <= (k) && (k) < hi)
#ifndef MK_DBL
#define MK_DBL -1
#endif
#define REPS(k) ((MK_DBL == (k)) ? 2 : 1)
#define STAMP(k) do { if (MK_PROBE_A >= 0 && blockIdx.x == 0 && F.tid == 0) F.MISC[16 + (k)] = (unsigned)__builtin_amdgcn_s_memrealtime(); } while (0)
#define SEAM(k) do { if (IN(k) && IN((k) + 1)) xcd_barrier(bar); STAMP((k) + 1); } while (0)
    const int gw = F.vcu * NWAVES + F.wave, NGW = F.G * NWAVES;
    STAMP(0);
    const float* x = args.in[0];
    bf16* xb = (bf16*)(ws + WS_XB);
    float* gates = (float*)(ws + WS_GATES);

    if (IN(0)) for (int rep = 0; rep < REPS(0); ++rep) { if (rep) xcd_barrier(bar);
        const float* g1 = args.in[1]; const float* w_in = args.in[2]; const float* w_out = args.in[18];
        const int nS5 = (F.G > 2 * SG) ? SG : 0;
        if (F.vcu < nS5 || nS5 == 0) {
            for (int rr = 0; rr < REPS(77); ++rr) for (int g = F.vcu; g < SG; g += (nS5 ? nS5 : F.G)) s5_gen(F, g, args.in[8], args.in[9], args.in[10], args.in[11], args.in[12], args.in[13], args.in[14], args.in[15], (bf16*)(ws + WS_TQ), (bf16*)(ws + WS_PG), (float*)(ws + WS_S5PAR));
        }
        STAMP(12);
        if (F.vcu >= nS5) {
            LAS float* wg = (LAS float*)(F.lds);
            for (int i = F.tid; i < 1024 * 8; i += NTHR) { const int k = i >> 3, c = i & 7; wg[i] = w_in[(size_t)k * NP + 2048 + c] * g1[k]; }
            __syncthreads();
            const float* ib = args.in[5]; const float* fb = args.in[6];
            const int rstride = (F.G - nS5) * NWAVES; int m = (F.vcu - nS5) * NWAVES + F.wave;
            f32x4 v[4];
            if (m < T) {
#pragma unroll
                for (int j = 0; j < 4; ++j) v[j] = ((const GAS f32x4*)(x + (size_t)m * D) + F.lane)[64 * j]; }
            while (m < T) {
                const int mn = m + rstride; f32x4 vn[4];
#pragma unroll
                for (int j = 0; j < 4; ++j) vn[j] = (f32x4){0.f, 0.f, 0.f, 0.f};
                if (mn < T) {
#pragma unroll
                    for (int j = 0; j < 4; ++j) vn[j] = ((const GAS f32x4*)(x + (size_t)mn * D) + F.lane)[64 * j]; }
                float s = 0.f;
#pragma unroll
                for (int j = 0; j < 4; ++j) s += (v[j].x * v[j].x + v[j].y * v[j].y) + (v[j].z * v[j].z + v[j].w * v[j].w);
                const float rs = rsqrtf(wave_sum(s) * (1.f / D) + EPS);
                float d[8] = {};
#pragma unroll
                for (int j = 0; j < 4; ++j) {
#pragma unroll
                    for (int q = 0; q < 4; ++q) { const int k = 4 * F.lane + 256 * j + q; const f32x4 w0 = *(const LAS f32x4*)(wg + k * 8), w1 = *(const LAS f32x4*)(wg + k * 8 + 4); const float xv = v[j][q] * rs;
                        d[0] += xv * w0.x; d[1] += xv * w0.y; d[2] += xv * w0.z; d[3] += xv * w0.w; d[4] += xv * w1.x; d[5] += xv * w1.y; d[6] += xv * w1.z; d[7] += xv * w1.w; } }
#pragma unroll
                for (int c = 0; c < 8; ++c) d[c] = wave_sum(d[c]);
                GAS unsigned long long* o8 = (GAS unsigned long long*)(xb + (size_t)m * D) + F.lane;
#pragma unroll
                for (int j = 0; j < 4; ++j) o8[64 * j] = (unsigned long long)pk2(v[j].x * rs, v[j].y * rs) | ((unsigned long long)pk2(v[j].z * rs, v[j].w * rs) << 32);
                if (F.lane < 8) { const int c = F.lane; float val = 0.f;
#pragma unroll
                    for (int q = 0; q < 8; ++q) val = (c == q) ? d[q] : val;
                    val = (c < 4) ? (val + ib[c & 3]) : log_sigmoidf_(val + fb[c & 3]); gates[(size_t)m * 8 + c] = val; }
#pragma unroll
                for (int j = 0; j < 4; ++j) v[j] = vn[j];
                m = mn;
            }
        }
        __syncthreads();
        STAMP(13);
        LAS unsigned char* scr = F.lds + F.wave * 8192;
        constexpr int I_IN = (D / 64) * (2560 / 64), I_OUT = (D / 64) * (D / 64);
        for (int it = gw; it < I_IN + I_OUT; it += NGW) {
            if (it < I_IN) { const int kb = it / 40, nb = it % 40, n0 = nb * 64; tconv64(w_in, NP, kb * 64, n0 < 2048 ? n0 : n0 + 8, (bf16*)(ws + WS_WIN), D, n0, g1, scr, F.lane); }
            else { const int r = it - I_IN, kb = r / 16, nb = r % 16; tconv64(w_out, D, kb * 64, nb * 64, (bf16*)(ws + WS_WOUT), D, nb * 64, nullptr, scr, F.lane); }
        }
        {
            const float* g2 = args.in[19]; const float* rgw = args.in[20]; const float* rew = args.in[22];
            bf16* wrh = (bf16*)(ws + WS_WRH); bf16* wrl = (bf16*)(ws + WS_WRL);
            for (int i = F.vcu * NTHR + F.tid; i < 48 * 1024; i += F.G * NTHR) { const int c = i >> 10, k = i & 1023;
                const float w = (c < 4) ? rgw[k * 4 + c] * g2[k] : (c < 36) ? rew[k * 32 + (c - 4)] * g2[k] : 0.f;
                const unsigned h = f2bf(w); wrh[i] = (bf16)h; wrl[i] = (bf16)f2bf(w - bf2f(h)); }
        }
        STAMP(14);
        __syncthreads();
    }
    STAMP(15);
    SEAM(0);
    if (IN(1)) {
        DenseSched S; S.init(xb, (const bf16*)(ws + WS_WIN), T, 2560, D, D, D, F.G, (int)blockIdx.x); S.reps = REPS(1);
        EpiInProj E{(bf16*)(ws + WS_QKVO), (bf16*)(ws + WS_AG)};
        pg8::gemm_phase<EpiInProj, DenseSched>(F.lds, S, E);
    }
    SEAM(1);
    if (IN(2)) {
        { S5ESched S; S.AG = (const bf16*)(ws + WS_AG); S.PG = (const bf16*)(ws + WS_PG); S.K = 512; S.lda = AGK; S.ldb = 512; S.G = F.G; S.c = (int)blockIdx.x; S.reps = REPS(20);
          EpiS5E E{(float*)(ws + WS_EE)};
          pg8::gemm_phase<EpiS5E, S5ESched>(F.lds, S, E); }
        __syncthreads();
        for (int p = F.vcu; p < 512 * REPS(2); p += F.G) mlstm_a_pair(F, p & 511, (const bf16*)(ws + WS_QKVO), gates, args.in[3], args.in[4], (bf16*)(ws + WS_DC), (float*)(ws + WS_DN), (float*)(ws + WS_MSC));
    }
    SEAM(2);
    if (IN(3)) {
        for (int bg = F.vcu; bg < 64; bg += F.G) s5_scan(F, bg, (const float*)(ws + WS_EE), (const float*)(ws + WS_S5PAR), (bf16*)(ws + WS_AG));
        __syncthreads();
        mlstm_b(F, (bf16*)(ws + WS_DC), (float*)(ws + WS_DN), (float*)(ws + WS_MSC));
    }
    SEAM(3);
    if (IN(4)) {
        { S5YSched S; S.AG = (const bf16*)(ws + WS_AG); S.TQ = (const bf16*)(ws + WS_TQ); S.K = AGK; S.lda = AGK; S.ldb = AGK; S.G = F.G; S.c = (int)blockIdx.x; S.reps = REPS(40);
          EpiS5Y E{(bf16*)(ws + WS_Y5)};
          pg8::gemm_phase<EpiS5Y, S5YSched>(F.lds, S, E); }
        __syncthreads();
        for (int p = F.vcu; p < 512 * REPS(4); p += F.G) mlstm_c_pair(F, p & 511, (const bf16*)(ws + WS_QKVO), gates, args.in[3], args.in[4], (const bf16*)(ws + WS_DC), (const float*)(ws + WS_DN), (const float*)(ws + WS_MSC), args.in[7], xb);
    }
    SEAM(4);
    if (IN(5)) for (int rep = 0; rep < REPS(5); ++rep) { if (rep) xcd_barrier(bar); s5_post(F, gw, NGW, (const bf16*)(ws + WS_Y5), args.in[16], args.in[17], xb); }
    SEAM(5);
    if (IN(6)) {
        DenseSched S; S.init(xb  , (const bf16*)(ws + WS_WOUT), T, D, D, D, D, F.G, (int)blockIdx.x); S.reps = REPS(6);
        EpiResF32 E{x, args.out};
        pg8::gemm_phase<EpiResF32, DenseSched>(F.lds, S, E);
    }
    SEAM(6);
    if (IN(7)) {
        const float* g2 = args.in[19]; const float* rgw = args.in[20]; const float* rgb = args.in[21]; const float* rew = args.in[22]; const float* reb = args.in[23];
        float* rs2o = (float*)(ws + WS_RS2); int* tok_e = (int*)(ws + WS_TOKE); float* tok_w = (float*)(ws + WS_TOKW); int* tok_p = (int*)(ws + WS_TOKP); int* list = (int*)(ws + WS_LIST);
        unsigned* cnt = F.ctl + CW_CNT; const float* x1 = args.out;
        const bf16* wrh = (const bf16*)(ws + WS_WRH); const bf16* wrl = (const bf16*)(ws + WS_WRL);
        constexpr int WROW = 1040, WHALF = 48 * WROW;
        LAS float* lg = (LAS float*)(F.lds + 102400 + (F.wave & 3) * 3072);
        LAS float* xch = (LAS float*)(F.lds + 102400 + 12288 + (F.wave & 3) * 3328);
        LAS unsigned* lcnt = (LAS unsigned*)(F.lds + LDS_AUX); LAS unsigned* lbase = lcnt + 32;
        const int khalf = F.wave >> 2;
        const int ntask = (T / 16 + 4 * F.G - 1) / (4 * F.G);
        for (int it = 0; it < ntask; ++it) {
            const int rt = (it * 4 + (F.wave & 3)) * F.G + F.vcu; const bool live = rt < T / 16;
            const int l15 = F.lane & 15, g4 = F.lane >> 4, row = (live ? rt : 0) * 16 + l15;
            const float* xr = x1 + (size_t)row * D + 8 * g4 + 512 * khalf; bf16* xo = xb + (size_t)row * D + 8 * g4 + 512 * khalf;
            const bf16* bl = wrl + (size_t)l15 * D + 8 * g4 + 512 * khalf;
            f32x4 areg[16];
#pragma unroll
            for (int i = 0; i < 16; ++i) areg[i] = *(const f32x4*)(xr + 32 * (i >> 1) + 4 * (i & 1));
            if (it == 0) {
                for (int i = F.tid; i < 48 * 128; i += NTHR) { const int col = i >> 7, c16 = i & 127, kh = c16 >> 6, w16 = c16 & 63;
                    *(LAS v4u*)(F.lds + kh * WHALF + col * WROW + w16 * 16) = *(const v4u*)(wrh + (size_t)col * D + c16 * 8); }
            }
            if (F.tid < 32) lcnt[F.tid] = 0u;
            __syncthreads();
            const LAS unsigned char* wl_h = F.lds + khalf * WHALF + l15 * WROW + g4 * 16;
            f32x4 acc[3]; acc[0] = acc[1] = acc[2] = (f32x4){0.f, 0.f, 0.f, 0.f}; float ss = 0.f;
#pragma unroll
            for (int ks = 0; ks < 16; ++ks) {
                const f32x4 a0 = areg[(2 * ks) & 15], a1 = areg[(2 * ks + 1) & 15];
                if (ks < 8) { areg[(2 * ks) & 15] = *(const f32x4*)(xr + 32 * (ks + 8)); areg[(2 * ks + 1) & 15] = *(const f32x4*)(xr + 32 * (ks + 8) + 4); }
                const float av[8] = {a0.x, a0.y, a0.z, a0.w, a1.x, a1.y, a1.z, a1.w};
                v4u ah4, al4;
#pragma unroll
                for (int j = 0; j < 4; ++j) { ss += av[2 * j] * av[2 * j] + av[2 * j + 1] * av[2 * j + 1]; const unsigned h2 = pk2(av[2 * j], av[2 * j + 1]); ah4[j] = h2;
                    al4[j] = pk2(av[2 * j] - bf2f(h2 & 0xffffu), av[2 * j + 1] - __builtin_bit_cast(float, h2 & 0xffff0000u)); }
                if (live) *(v4u*)(xo + 32 * ks) = ah4;
                const bf16x8 ah = __builtin_bit_cast(bf16x8, ah4), al = __builtin_bit_cast(bf16x8, al4);
#pragma unroll
                for (int ct = 0; ct < 3; ++ct) { const bf16x8 wh = *(const LAS bf16x8*)(wl_h + ct * 16 * WROW + ks * 64), wl = *(const bf16x8*)(bl + (size_t)ct * 16 * D + 32 * ks);
                    acc[ct] = __builtin_amdgcn_mfma_f32_16x16x32_bf16(ah, wh, acc[ct], 0, 0, 0);
                    acc[ct] = __builtin_amdgcn_mfma_f32_16x16x32_bf16(al, wh, acc[ct], 0, 0, 0);
                    acc[ct] = __builtin_amdgcn_mfma_f32_16x16x32_bf16(ah, wl, acc[ct], 0, 0, 0); }
            }
            STAMP(22);
            if (khalf) {
#pragma unroll
                for (int ct = 0; ct < 3; ++ct)
#pragma unroll
                    for (int r = 0; r < 4; ++r) xch[(ct * 4 + r) * 64 + F.lane] = acc[ct][r];
                xch[12 * 64 + F.lane] = ss; }
            __syncthreads();
            STAMP(23);
            int e0 = 0, e1 = 0, r0 = 0, r1 = 0; float w0 = 0.f, w1 = 0.f, rs = 0.f;
            const bool sel = (!khalf && live && F.lane < 16);
            if (!khalf && live) {
#pragma unroll
                for (int ct = 0; ct < 3; ++ct)
#pragma unroll
                    for (int r = 0; r < 4; ++r) acc[ct][r] += xch[(ct * 4 + r) * 64 + F.lane];
                ss += xch[12 * 64 + F.lane];
                ss += __shfl_xor(ss, 16); ss += __shfl_xor(ss, 32);
                rs = rsqrtf(ss * (1.f / D) + EPS);
#pragma unroll
                for (int r = 0; r < 4; ++r) { const float rr = __shfl(rs, 4 * g4 + r);
#pragma unroll
                    for (int ct = 0; ct < 3; ++ct) lg[(4 * g4 + r) * 48 + 16 * ct + l15] = acc[ct][r] * rr; }
                asm volatile("s_waitcnt lgkmcnt(0)" ::: "memory");
                if (F.lane < 16) {
                    const LAS float* lr = lg + F.lane * 48;
                    float gl[4];
#pragma unroll
                    for (int c = 0; c < 4; ++c) gl[c] = lr[c] + rgb[c];
                    int gi = 0; float gm = gl[0];
#pragma unroll
                    for (int c = 1; c < 4; ++c) if (gl[c] > gm) { gm = gl[c]; gi = c; }
                    float gs = 0.f;
#pragma unroll
                    for (int c = 0; c < 4; ++c) gs += expf(gl[c] - gm);
                    const float gwt = 1.f / gs;
                    float el[8];
#pragma unroll
                    for (int c = 0; c < 8; ++c) el[c] = lr[4 + gi * 8 + c] + reb[gi * 8 + c];
                    int i0 = 0; float m0 = el[0];
#pragma unroll
                    for (int c = 1; c < 8; ++c) if (el[c] > m0) { m0 = el[c]; i0 = c; }
                    int i1 = 0; float m1 = -INFINITY;
#pragma unroll
                    for (int c = 0; c < 8; ++c) if (c != i0 && el[c] > m1) { m1 = el[c]; i1 = c; }
                    const float p1 = expf(m1 - m0);
                    w0 = gwt / (1.f + p1); w1 = gwt * p1 / (1.f + p1);
                    e0 = gi * 8 + i0; e1 = gi * 8 + i1;
                    r0 = (int)__hip_atomic_fetch_add(&lcnt[e0], 1u, __ATOMIC_RELAXED, __HIP_MEMORY_SCOPE_WORKGROUP); r1 = (int)__hip_atomic_fetch_add(&lcnt[e1], 1u, __ATOMIC_RELAXED, __HIP_MEMORY_SCOPE_WORKGROUP);
                }
            }
            __syncthreads();
            if (F.tid < 32) { const unsigned c = lcnt[F.tid]; lbase[F.tid] = c ? atomicAdd(&cnt[F.tid], c) : 0u; }
            __syncthreads();
            if (sel) {
                const int t = rt * 16 + F.lane;
                const int p0 = (int)lbase[e0] + r0, p1i = (int)lbase[e1] + r1;
                rs2o[t] = rs;
                list[e0 * T + p0] = t; list[e1 * T + p1i] = t;
                tok_e[2 * t] = e0; tok_e[2 * t + 1] = e1; tok_w[2 * t] = w0; tok_w[2 * t + 1] = w1; tok_p[2 * t] = p0; tok_p[2 * t + 1] = p1i;
            }
            __syncthreads();
        }
        STAMP(16);
        __syncthreads();
        LAS unsigned char* scr = F.lds + F.wave * 8192;
        const float* Wg = args.in[24]; const float* Wu = args.in[25]; const float* Wd = args.in[26];
        bf16* wgu = (bf16*)(ws + WS_WGU); bf16* wd = (bf16*)(ws + WS_WD);
        constexpr int NIT = NE * 384, NIT_HI = (NIT * 2) / 3;
        const int half4 = F.wave >> 2, j4 = F.vcu * 4 + (F.wave & 3), n4 = F.G * 4;
        for (int it0 = (half4 ? 0 : NIT_HI) + j4; it0 < (half4 ? NIT_HI : NIT); it0 += n4) { const int it = it0;
            const int e = it / 384, r = it % 384;
            if (r < 256) { const int up = r >> 7, rr = r & 127, kb = rr >> 3, nb = rr & 7, n0 = nb * 64;
                const int drow = (n0 >> 7) * 256 + up * 128 + (n0 & 127);
                tconv64((up ? Wu : Wg) + (size_t)e * D * DE, DE, kb * 64, n0, wgu + (size_t)e * 1024 * 1024, D, drow, g2, scr, F.lane); }
            else { const int rr = r - 256, kb = rr >> 4, nb = rr & 15; tconv64(Wd + (size_t)e * DE * D, D, kb * 64, nb * 64, wd + (size_t)e * 1024 * 512, DE, nb * 64, nullptr, scr, F.lane); }
        }
    }
    STAMP(17);
    SEAM(7);
    if (IN(8) || IN(9)) {
        LAS int* toff = (LAS int*)(F.lds + LDS_AUX); LAS int* soff = toff + 40; LAS int* tokl = toff + 128;
        if (F.tid == 0) { int a = 0, b = 0; for (int e = 0; e < NE; ++e) { const int c = (int)xb_ld(F.ctl + CW_CNT + e); toff[e] = a; soff[e] = b; a += (c + 255) >> 8; b += c; } toff[NE] = a; soff[NE] = b; }
        __syncthreads();
        MoeSched S; S.G = F.G; S.c = F.vcu; S.toff = toff; S.soff = soff; S.tokl = tokl; S.nunits = toff[NE] * 4; S.reps = 1;
        S.A = xb; S.Bt = (const bf16*)(ws + WS_WGU); S.K = D; S.lda = D; S.ldb = D; S.bstride = (size_t)1024 * 1024; S.gather = true;
        if (IN(8)) {
            const int* list = (const int*)(ws + WS_LIST); S.reps = REPS(8);
            for (int i = 0; i < MOE_MAXU; ++i) { pg8::Unit u; if (!S.next(i, u)) break; if (F.tid < 256) { const int r = min(F.tid, u.rows - 1); tokl[i * 256 + F.tid] = list[u.e * T + u.pm * 256 + r]; } }
            __syncthreads();
            S.reps = REPS(8);
            EpiGateUp E{(bf16*)(ws + WS_H), tokl, (const float*)(ws + WS_RS2)};
            pg8::gemm_phase<EpiGateUp, MoeSched>(F.lds, S, E);
        }
        SEAM(8);
        if (IN(9)) {
            S.A = (const bf16*)(ws + WS_H); S.Bt = (const bf16*)(ws + WS_WD); S.K = DE; S.lda = DE; S.ldb = DE; S.bstride = (size_t)1024 * 512; S.gather = false; S.reps = REPS(9);
            EpiDown E{(bf16*)(ws + WS_Y)};
            pg8::gemm_phase<EpiDown, MoeSched>(F.lds, S, E);
        }
    }
    SEAM(9);
    if (IN(10)) {
        LAS int* soff = (LAS int*)(F.lds + LDS_AUX) + 40;
        if (!IN(9)) { if (F.tid == 0) { int b = 0; for (int e = 0; e < NE; ++e) { soff[e] = b; b += (int)xb_ld(F.ctl + CW_CNT + e); } } __syncthreads(); }
        const float* gf = args.in[27]; const int* tok_e = (const int*)(ws + WS_TOKE); const float* tok_w = (const float*)(ws + WS_TOKW); const int* tok_p = (const int*)(ws + WS_TOKP);
        const bf16* Y = (const bf16*)(ws + WS_Y); float* out = args.out;
        for (int t = gw; t < T; t += NGW) {
            const int s0 = soff[tok_e[2 * t]] + tok_p[2 * t], s1 = soff[tok_e[2 * t + 1]] + tok_p[2 * t + 1]; const float w0 = tok_w[2 * t], w1 = tok_w[2 * t + 1];
            f32x4 v[4]; float s = 0.f;
#pragma unroll
            for (int j = 0; j < 4; ++j) {
                const f32x4 a = ((const GAS f32x4*)(out + (size_t)t * D) + F.lane)[64 * j];
                const v2u y0 = ((const GAS v2u*)(Y + (size_t)s0 * D) + F.lane)[64 * j], y1 = ((const GAS v2u*)(Y + (size_t)s1 * D) + F.lane)[64 * j];
                v[j].x = a.x + (w0 * bf2f(y0.x & 0xffffu) + w1 * bf2f(y1.x & 0xffffu)); v[j].y = a.y + (w0 * bf2f(y0.x >> 16) + w1 * bf2f(y1.x >> 16));
                v[j].z = a.z + (w0 * bf2f(y0.y & 0xffffu) + w1 * bf2f(y1.y & 0xffffu)); v[j].w = a.w + (w0 * bf2f(y0.y >> 16) + w1 * bf2f(y1.y >> 16));
                s += (v[j].x * v[j].x + v[j].y * v[j].y) + (v[j].z * v[j].z + v[j].w * v[j].w); }
            const float rs = rsqrtf(wave_sum(s) * (1.f / D) + EPS);
#pragma unroll
            for (int j = 0; j < 4; ++j) { const f32x4 gg = ((const GAS f32x4*)gf + F.lane)[64 * j]; ((GAS f32x4*)(out + (size_t)t * D) + F.lane)[64 * j] = (f32x4){v[j].x * rs * gg.x, v[j].y * rs * gg.y, v[j].z * rs * gg.z, v[j].w * rs * gg.w}; }
        }
    }
    if (MK_PROBE_A >= 0 && IN(10) && blockIdx.x == 0 && F.tid == 0) {
        STAMP(11);
        const unsigned dtk = F.MISC[16 + MK_PROBE_B] - F.MISC[16 + MK_PROBE_A];
        args.out[0] += (float)((dtk / 1600u) * 4u) * MK_PROBE_SCALE;
    }
#undef IN
#undef SEAM
}

extern "C" void kernel_launch(void* const* d_in, const int* in_sizes, int n_in, void* d_out, int out_size, void* d_ws, size_t ws_size, hipStream_t stream) {
    static int grid = 0;
    if (grid == 0) {
        int dev = 0, cus = 0, per_cu = 0;
        if (hipGetDevice(&dev) != hipSuccess || hipDeviceGetAttribute(&cus, hipDeviceAttributeMultiprocessorCount, dev) != hipSuccess) { grid = -1; return; }
        if (hipFuncSetAttribute((const void*)mk_fwd, hipFuncAttributeMaxDynamicSharedMemorySize, LDS_BYTES) != hipSuccess) { grid = -1; return; }
        if (hipOccupancyMaxActiveBlocksPerMultiprocessor(&per_cu, (const void*)mk_fwd, NTHR, LDS_BYTES) != hipSuccess || per_cu < 1) per_cu = 1;
        (void)hipGetLastError();
        grid = cus;
    }
    if (grid < 0) return;
    unsigned char* ws = (unsigned char*)d_ws;
    (void)hipMemsetAsync(ws + WS_CTL, 0, CTL_ZERO_BYTES, stream);
    Args a{};
    for (int i = 0; i < 28; ++i) a.in[i] = (const float*)d_in[i];
    a.out = (float*)d_out; a.ws = ws;
    auto launch = [&](int lo, int hi) { a.ph_lo = lo; a.ph_hi = hi; hipLaunchKernelGGL(mk_fwd, dim3(grid), dim3(NTHR), LDS_BYTES, stream, a); };
#ifndef MK_SPLIT
#define MK_SPLIT 0
#endif
    if (MK_SPLIT) { for (int p = 0; p < 11; ++p) launch(p, p + 1); }
    else launch(0, 11);
}
```
